# Optimizing an MI355X kernel written in HIP

```python
import jax, jax.numpy as jnp
from jax import lax
import numpy as np

D_MODEL = 1024
BATCH = 4
SEQ = 4096
DEPTH = 2

N_MIXERS = 2
HEAD_SIZE = 64
N_HEADS = D_MODEL // HEAD_SIZE
DECAY_LORA = 64
ICLR_LORA = 64
GATE_LORA = 160
GN_EPS = 64e-5
LRU_WIDTH = D_MODEL
LRU_BLOCK = 256
LRU_BLOCKS = LRU_WIDTH // LRU_BLOCK
CONV_WIDTH = 4
LRU_C = 8.0
D_FF = 7 * D_MODEL // 2
N_EXPERTS = 8
TOP_K = 2
NORM_EPS = 1e-6
N_RWKV = (DEPTH + 1) // 2
N_LRU = DEPTH // 2
N_DENSE = (DEPTH + 1) // 2
N_MOE = DEPTH // 2

kernel_name = 'hybrid_rwkv7_rglru_moe_adaln'


def rmsnorm(x, g):
    xf = x.astype(jnp.float32)
    y = xf * lax.rsqrt(jnp.mean(xf * xf, axis=-1, keepdims=True) + NORM_EPS)
    return (y * g.astype(jnp.float32)).astype(x.dtype)


def modulate(x, g, shift, scale):
    return rmsnorm(x, g) * (1.0 + scale[:, None, :]) + shift[:, None, :]


def causal_shift(x):
    return jnp.pad(x, ((0, 0), (1, 0), (0, 0)))[:, :-1]


def wkv7_scan(r, w, k, v, a_in, b_in):
    B, T, H, N = r.shape
    xs = tuple(jnp.moveaxis(t, 1, 0) for t in (r, w, k, v, a_in, b_in))

    def step(S, inp):
        r_t, w_t, k_t, v_t, a_t, b_t = inp
        sa = jnp.einsum('bhvk,bhk->bhv', S, a_t)
        S = S * w_t[:, :, None, :] + sa[..., None] * b_t[:, :, None, :] + v_t[..., None] * k_t[:, :, None, :]
        return S, jnp.einsum('bhvk,bhk->bhv', S, r_t)

    S0 = jnp.zeros((B, H, N, N), jnp.float32)
    _, ys = lax.scan(step, S0, xs)
    return jnp.moveaxis(ys, 0, 1)


def rwkv7_time_mix(h, mu, w_rkv, w_o, w0, w1, w2, a0, a1, a2, g1, g2, k_k, k_a, r_k, gn_w, gn_b):
    B, T, C = h.shape
    f32 = jnp.float32
    xx = causal_shift(h) - h
    xm = h[None] + xx[None] * mu[:, None, None, :]
    r, k, v = jnp.einsum('pbtc,pcd->pbtd', xm[:3], w_rkv)
    xw, xa, xg = xm[3], xm[4], xm[5]
    w_log = -jax.nn.softplus(-(w0 + jnp.tanh(xw @ w1) @ w2).astype(f32)) - 0.5
    decay = jnp.exp(-jnp.exp(w_log))
    a = jax.nn.sigmoid((a0 + (xa @ a1) @ a2).astype(f32))
    g = jax.nn.sigmoid(xg @ g1) @ g2

    def heads(t):
        return t.astype(f32).reshape(B, T, N_HEADS, HEAD_SIZE)

    r_h, k_h, v_h, a_h, w_h = heads(r), heads(k), heads(v), heads(a), heads(decay)
    kk = k_h * k_k.reshape(N_HEADS, HEAD_SIZE)
    kk = kk / jnp.maximum(jnp.linalg.norm(kk, axis=-1, keepdims=True), 1e-12)
    k_h = k_h * (1.0 + (a_h - 1.0) * k_a.reshape(N_HEADS, HEAD_SIZE))
    y = wkv7_scan(r_h, w_h, k_h, v_h, -kk, kk * a_h)
    mean = jnp.mean(y, axis=-1, keepdims=True)
    var = jnp.mean(jnp.square(y - mean), axis=-1, keepdims=True)
    y = ((y - mean) * lax.rsqrt(var + GN_EPS)).reshape(B, T, C) * gn_w + gn_b
    bonus = jnp.sum(r_h * k_h * r_k, axis=-1, keepdims=True) * v_h
    y = (y + bonus.reshape(B, T, C)) * g
    return y.astype(h.dtype) @ w_o


def rglru_block(h, w_in, conv_w, conv_b, w_gates, b_gates, lam, w_out):
    B, T, _ = h.shape
    f32 = jnp.float32
    xb, gb = jnp.split(h @ w_in, 2, axis=-1)
    gate = jax.nn.gelu(gb)
    xb = lax.conv_general_dilated(xb, conv_w[:, None, :], window_strides=(1,),
                                  padding=[(CONV_WIDTH - 1, 0)],
                                  dimension_numbers=('NWC', 'WIO', 'NWC'),
                                  feature_group_count=LRU_WIDTH) + conv_b
    xh = xb.reshape(B, T, LRU_BLOCKS, LRU_BLOCK)
    gates = jnp.einsum('btnh,nhg->btng', xh, w_gates) + b_gates
    r_t, i_t = jnp.split(jax.nn.sigmoid(gates.astype(f32)), 2, axis=-1)
    r_t = r_t.reshape(B, T, LRU_WIDTH)
    i_t = i_t.reshape(B, T, LRU_WIDTH)
    log_a = -LRU_C * r_t * jax.nn.softplus(-lam.astype(f32))
    a_t = jnp.exp(log_a)
    b_t = jnp.sqrt(-jnp.expm1(2.0 * log_a)) * (i_t * xb.astype(f32))

    def combine(c1, c2):
        return c1[0] * c2[0], c2[0] * c1[1] + c2[1]

    _, hs = lax.associative_scan(combine, (a_t, b_t), axis=1)
    return (hs.astype(h.dtype) * gate) @ w_out


def swiglu(h, w_gu, w_d):
    g, u = jnp.split(h @ w_gu, 2, axis=-1)
    return (jax.nn.silu(g) * u) @ w_d


def moe_swiglu(h, w_router, b_router, w_gu, w_d):
    B, T, D = h.shape
    t = h.reshape(B * T, D)
    logits = (t @ w_router + b_router).astype(jnp.float32)
    top_v, top_i = lax.top_k(logits, TOP_K)
    probs = jax.nn.softmax(top_v, axis=-1)
    comb = jnp.einsum('nk,nke->ne', probs, jax.nn.one_hot(top_i, N_EXPERTS, dtype=jnp.float32))
    out = jnp.zeros_like(t)
    for e in range(N_EXPERTS):
        out = out + comb[:, e, None].astype(t.dtype) * swiglu(t, w_gu[e], w_d[e])
    return out.reshape(B, T, D)


def setup_inputs(seed: int = 0) -> dict:
    key = jax.random.key(seed)
    counter = [0]

    def nxt():
        counter[0] += 1
        return jax.random.fold_in(key, counter[0])

    def nrm(shape, scale):
        return jax.random.normal(nxt(), shape, jnp.float32) * scale

    def unif(shape, lo, hi):
        return jax.random.uniform(nxt(), shape, jnp.float32, lo, hi)

    D, F, E, W = D_MODEL, D_FF, N_EXPERTS, LRU_WIDTH
    NR, NL, ND, NM = N_RWKV, N_LRU, N_DENSE, N_MOE
    u = unif((NL, W), 0.9, 0.999)
    a_base = u ** (1.0 / LRU_C)
    lam = jnp.log(a_base) - jnp.log1p(-a_base)
    return {
        'x': nrm((BATCH, SEQ, D), 1.0),
        'c': nrm((BATCH, D), 1.0),
        'ada_w': nrm((DEPTH, D, 6 * D), 0.1 * D ** -0.5),
        'ada_b': nrm((DEPTH, 6 * D), 0.01),
        'norm_g': 1.0 + nrm((DEPTH, 2, D), 0.05),
        'final_g': 1.0 + nrm((D,), 0.05),
        'rwkv_mu': unif((NR, 6, D), 0.0, 1.0),
        'rwkv_w_rkv': nrm((NR, 3, D, D), D ** -0.5),
        'rwkv_w_o': nrm((NR, D, D), D ** -0.5),
        'rwkv_w0': unif((NR, D), -6.0, -1.0),
        'rwkv_w1': nrm((NR, D, DECAY_LORA), 0.1 * D ** -0.5),
        'rwkv_w2': nrm((NR, DECAY_LORA, D), 0.1 * DECAY_LORA ** -0.5),
        'rwkv_a0': nrm((NR, D), 0.1),
        'rwkv_a1': nrm((NR, D, ICLR_LORA), D ** -0.5),
        'rwkv_a2': nrm((NR, ICLR_LORA, D), 0.1 * ICLR_LORA ** -0.5),
        'rwkv_g1': nrm((NR, D, GATE_LORA), D ** -0.5),
        'rwkv_g2': nrm((NR, GATE_LORA, D), GATE_LORA ** -0.5),
        'rwkv_k_k': 0.85 + nrm((NR, D), 0.05),
        'rwkv_k_a': 1.0 + nrm((NR, D), 0.05),
        'rwkv_r_k': nrm((NR, N_HEADS, HEAD_SIZE), 0.1),
        'rwkv_gn_w': 1.0 + nrm((NR, D), 0.05),
        'rwkv_gn_b': nrm((NR, D), 0.01),
        'lru_w_in': nrm((NL, D, 2 * W), D ** -0.5),
        'lru_conv_w': nrm((NL, CONV_WIDTH, W), CONV_WIDTH ** -0.5),
        'lru_conv_b': nrm((NL, W), 0.01),
        'lru_w_gates': nrm((NL, LRU_BLOCKS, LRU_BLOCK, 2 * LRU_BLOCK), LRU_BLOCK ** -0.5),
        'lru_b_gates': nrm((NL, LRU_BLOCKS, 2 * LRU_BLOCK), 0.01),
        'lru_lam': lam,
        'lru_w_out': nrm((NL, W, D), W ** -0.5),
        'ffn_w_gu': nrm((ND, D, 2 * F), D ** -0.5),
        'ffn_w_d': nrm((ND, F, D), F ** -0.5),
        'moe_w_router': nrm((NM, D, E), D ** -0.5),
        'moe_b_router': nrm((NM, E), 0.01),
        'moe_w_gu': nrm((NM, E, D, 2 * F), D ** -0.5),
        'moe_w_d': nrm((NM, E, F, D), F ** -0.5),
    }


def reference(x, c, ada_w, ada_b, norm_g, final_g,
              rwkv_mu, rwkv_w_rkv, rwkv_w_o, rwkv_w0, rwkv_w1, rwkv_w2, rwkv_a0, rwkv_a1, rwkv_a2,
              rwkv_g1, rwkv_g2, rwkv_k_k, rwkv_k_a, rwkv_r_k, rwkv_gn_w, rwkv_gn_b,
              lru_w_in, lru_conv_w, lru_conv_b, lru_w_gates, lru_b_gates, lru_lam, lru_w_out,
              ffn_w_gu, ffn_w_d, moe_w_router, moe_b_router, moe_w_gu, moe_w_d):
    cond = jax.nn.silu(c)
    for i in range(DEPTH):
        j = i // N_MIXERS
        mod = cond @ ada_w[i] + ada_b[i]
        sh1, sc1, gt1, sh2, sc2, gt2 = jnp.split(mod, 6, axis=-1)
        h = modulate(x, norm_g[i, 0], sh1, sc1)
        if i % N_MIXERS == 0:
            y = rwkv7_time_mix(h, rwkv_mu[j], rwkv_w_rkv[j], rwkv_w_o[j], rwkv_w0[j], rwkv_w1[j], rwkv_w2[j],
                               rwkv_a0[j], rwkv_a1[j], rwkv_a2[j], rwkv_g1[j], rwkv_g2[j], rwkv_k_k[j],
                               rwkv_k_a[j], rwkv_r_k[j], rwkv_gn_w[j], rwkv_gn_b[j])
        else:
            y = rglru_block(h, lru_w_in[j], lru_conv_w[j], lru_conv_b[j], lru_w_gates[j], lru_b_gates[j],
                            lru_lam[j], lru_w_out[j])
        x = x + ((1.0 + gt1)[:, None, :] * y).astype(x.dtype)
        h = modulate(x, norm_g[i, 1], sh2, sc2)
        if i % 2 == 0:
            y = swiglu(h, ffn_w_gu[i // 2], ffn_w_d[i // 2])
        else:
            y = moe_swiglu(h, moe_w_router[i // 2], moe_b_router[i // 2], moe_w_gu[i // 2], moe_w_d[i // 2])
        x = x + ((1.0 + gt2)[:, None, :] * y).astype(x.dtype)
    return rmsnorm(x, final_g)
```

```cpp
#include <hip/hip_runtime.h>
#include <cstdio>
#include <cstdint>

#define GAS __attribute__((address_space(1)))
#define LAS __attribute__((address_space(3)))
typedef unsigned short bf16;
typedef short bf16x8 __attribute__((ext_vector_type(8)));
typedef float f32x4 __attribute__((ext_vector_type(4)));
typedef float f32x2 __attribute__((ext_vector_type(2)));
typedef unsigned u32x4 __attribute__((ext_vector_type(4)));
typedef unsigned u32x2 __attribute__((ext_vector_type(2)));
typedef int i32x2 __attribute__((ext_vector_type(2)));

#ifndef PROBE_REP
#define PROBE_REP 1
#endif
#ifndef WKV_MODE
#define WKV_MODE 2
#endif
#ifndef MOE_FP8
#define MOE_FP8 1
#endif
#ifndef FFN_I8
#define FFN_I8 1
#endif
#ifndef MD_TAIL
#define MD_TAIL 1
#endif
#ifndef FFN_FP8
#define FFN_FP8 0
#endif
#ifndef X_BF16
#define X_BF16 1
#endif
#ifndef FUSE_MOD
#define FUSE_MOD 0
#endif
#ifndef STAGE
#define STAGE 4
#endif
#ifndef FAST_GEMM
#define FAST_GEMM 1
#endif

constexpr int NB = 4, T = 4096, D = 1024, M = NB * T, NH = 16, HS = 64, FF = 3584, NE = 8;
constexpr int MODW = 6 * D;
constexpr int MPAD = 2 * M + NE * 256;
constexpr int NWAVES = 8, NTHR = 512;

constexpr size_t MiB = 1u << 20;
constexpr size_t WS_CTL = 0, CTL_ZERO_BYTES = 64 * 1024;
constexpr size_t WS_MOD = 1 * MiB;
constexpr size_t WS_CNT = 1 * MiB + 256 * 1024;
constexpr size_t WS_PST = WS_CNT + 16 * 1024;
constexpr size_t WS_SEL = 2 * MiB;
constexpr size_t WS_PROB = WS_SEL + 128 * 1024;
constexpr size_t WS_POS = WS_PROB + 128 * 1024;
constexpr size_t WS_XSL = 3 * MiB;
constexpr int CW_SEAM = 16384;
constexpr size_t WS_SA = 3 * MiB + 512 * 1024;
constexpr size_t WS_AMAX = WS_CTL + 32;
constexpr size_t WS_WRKV = 4 * MiB, WS_L1T = 10 * MiB, WS_L2T = 12 * MiB, WS_WO = 14 * MiB, WS_WGU = 16 * MiB, WS_WD = 30 * MiB;
constexpr size_t WS_WIN = 37 * MiB, WS_WG = 41 * MiB, WS_WOUT = 42 * MiB, WS_MGU = 44 * MiB, WS_MD = 156 * MiB, WS_ARENA = 212 * MiB;
constexpr size_t A_XM = WS_ARENA, A_RKV = WS_ARENA + 192 * MiB, A_L1O = WS_ARENA + 288 * MiB, A_L2O = WS_ARENA + 312 * MiB, A_Y = WS_ARENA + 408 * MiB, A_YG = WS_ARENA + 472 * MiB;
constexpr size_t A_H = WS_ARENA, A_ACT = WS_ARENA + 32 * MiB;
constexpr size_t A_XB = WS_ARENA + 32 * MiB, A_GATE = WS_ARENA + 64 * MiB, A_XBC = WS_ARENA + 96 * MiB, A_AT = WS_ARENA + 128 * MiB, A_BT = WS_ARENA + 192 * MiB, A_HG = WS_ARENA + 256 * MiB, A_CAR = WS_ARENA + 288 * MiB;
constexpr size_t A_HS = WS_ARENA + 32 * MiB, A_MACT = WS_ARENA + 100 * MiB, A_YD = WS_ARENA + 338 * MiB;
constexpr size_t A_YDP = WS_ARENA + 408 * MiB;
constexpr int CW_BAR = 4096;
constexpr int CW_TAIL = 64;
constexpr size_t WS_X16 = WS_ARENA + 504 * MiB;
constexpr size_t WS_END = WS_ARENA + 536 * MiB;
static_assert(A_HS + (size_t)MPAD * D * 2 <= A_MACT && A_MACT + (size_t)MPAD * FF * 2 <= A_YD && A_YD + (size_t)MPAD * D * 4 <= WS_END, "moe arena");

constexpr int LDS_BYTES = 147456;
constexpr int RING_BYTES = 131072;
constexpr int MISC_OFF = LDS_BYTES - 512;

struct Args {
    const float* in[35];
    float* out;
    unsigned char* ws;
};
enum { I_X = 0, I_C, I_ADAW, I_ADAB, I_NORMG, I_FINALG, I_MU, I_WRKV, I_WO, I_W0, I_W1, I_W2, I_A0, I_A1, I_A2, I_G1, I_G2, I_KK, I_KA, I_RK, I_GNW, I_GNB,
       I_WIN, I_CONVW, I_CONVB, I_WGATES, I_BGATES, I_LAM, I_WOUT, I_FGU, I_FD, I_ROUTW, I_ROUTB, I_MGU, I_MD };

__device__ __forceinline__ float bf2f(unsigned v) { return __uint_as_float(v << 16); }
typedef __bf16 bf16x2_t __attribute__((ext_vector_type(2)));
__device__ __forceinline__ unsigned cvt_pk_bf16(float lo, float hi) { const f32x2 v = {lo, hi}; const bf16x2_t b = __builtin_convertvector(v, bf16x2_t); return __builtin_bit_cast(unsigned, b); }
__device__ __forceinline__ u32x2 pk4(const f32x4 v) { u32x2 w; w.x = cvt_pk_bf16(v[0], v[1]); w.y = cvt_pk_bf16(v[2], v[3]); return w; }
__device__ __forceinline__ f32x4 unpk4(const u32x2 w) { return (f32x4){bf2f(w.x & 0xffffu), __uint_as_float(w.x & 0xffff0000u), bf2f(w.y & 0xffffu), __uint_as_float(w.y & 0xffff0000u)}; }
__device__ __forceinline__ unsigned pk_fp8x4(float a, float b, float c, float d) { int w = __builtin_amdgcn_cvt_pk_fp8_f32(a, b, 0, false); w = __builtin_amdgcn_cvt_pk_fp8_f32(c, d, w, true); return (unsigned)w; }
constexpr float F8_WSCALE = 64.0f;
#if X_BF16
typedef bf16 xres_t;
__device__ __forceinline__ f32x4 xload4(const xres_t* row, int idx4) { return unpk4(((const u32x2*)row)[idx4]); }
__device__ __forceinline__ void xstore4(xres_t* p, const f32x4 v) { *(u32x2*)p = pk4(v); }
#else
typedef float xres_t;
__device__ __forceinline__ f32x4 xload4(const xres_t* row, int idx4) { return ((const f32x4*)row)[idx4]; }
__device__ __forceinline__ void xstore4(xres_t* p, const f32x4 v) { *(f32x4*)p = v; }
#endif
#define XRES(a) (X_BF16 ? (xres_t*)((a).ws + WS_X16) : (xres_t*)(a).out)
template <class TX> __device__ __forceinline__ f32x4 ld4any(const TX* row, int idx4);
template <> __device__ __forceinline__ f32x4 ld4any<float>(const float* row, int idx4) { return ((const f32x4*)row)[idx4]; }
template <> __device__ __forceinline__ f32x4 ld4any<bf16>(const bf16* row, int idx4) { return unpk4(((const u32x2*)row)[idx4]); }
__device__ __forceinline__ float dppx(float x, const int sel) {
    const int xi = __builtin_bit_cast(int, x); int r;
    if (sel == 0) r = __builtin_amdgcn_update_dpp(0, xi, 0xB1, 0xF, 0xF, true); else if (sel == 1) r = __builtin_amdgcn_update_dpp(0, xi, 0x4E, 0xF, 0xF, true);
    else if (sel == 2) r = __builtin_amdgcn_update_dpp(0, xi, 0x141, 0xF, 0xF, true); else r = __builtin_amdgcn_update_dpp(0, xi, 0x140, 0xF, 0xF, true);
    return __builtin_bit_cast(float, r);
}
__device__ __forceinline__ float rlane(float v, int l) { return __builtin_bit_cast(float, __builtin_amdgcn_readlane(__builtin_bit_cast(int, v), l)); }
__device__ __forceinline__ float wave_sum(float v) { v += dppx(v, 0); v += dppx(v, 1); v += dppx(v, 2); v += dppx(v, 3); return (rlane(v, 0) + rlane(v, 16)) + (rlane(v, 32) + rlane(v, 48)); }
__device__ __forceinline__ float wave_max(float v) { v = fmaxf(v, dppx(v, 0)); v = fmaxf(v, dppx(v, 1)); v = fmaxf(v, dppx(v, 2)); v = fmaxf(v, dppx(v, 3)); return fmaxf(fmaxf(rlane(v, 0), rlane(v, 16)), fmaxf(rlane(v, 32), rlane(v, 48))); }
__device__ __forceinline__ float sigmoidf_(float x) { return __builtin_amdgcn_rcpf(1.0f + __expf(-x)); }
__device__ __forceinline__ float softplusf_(float z) { return fmaxf(z, 0.f) + __logf(1.0f + __expf(-fabsf(z))); }
__device__ __forceinline__ float siluf_(float x) { return x * __builtin_amdgcn_rcpf(1.0f + __expf(-x)); }
__device__ __forceinline__ float tanhf_(float x) { return 1.0f - 2.0f * __builtin_amdgcn_rcpf(__expf(2.0f * x) + 1.0f); }
__device__ __forceinline__ float gelu_tanh(float x) { const float u = 0.7978845608028654f * (x + 0.044715f * x * x * x); return 0.5f * x * (1.0f + tanhf_(u)); }
__device__ __forceinline__ void unpack8(const u32x4 w, float (&f)[8]) {
    f[0] = bf2f(w.x & 0xffffu); f[1] = __uint_as_float(w.x & 0xffff0000u); f[2] = bf2f(w.y & 0xffffu); f[3] = __uint_as_float(w.y & 0xffff0000u);
    f[4] = bf2f(w.z & 0xffffu); f[5] = __uint_as_float(w.z & 0xffff0000u); f[6] = bf2f(w.w & 0xffffu); f[7] = __uint_as_float(w.w & 0xffff0000u);
}

constexpr int BM = 256, BK = 64, HALF = 128, HTB = HALF * BK * 2, NXCD = 8, WGM = 8;
struct Unit { int pm, pn, z; const char* A; const char* B; };
struct GemmDims { int K, lda, ldb; };

__device__ __forceinline__ void map_unit(int L, int nM, int nN, int& pm, int& pn) {
    const int nwg = nM * nN; int wgid = L;
    { const int q = nwg / NXCD, r = nwg % NXCD, xcd = wgid % NXCD, off = wgid / NXCD; wgid = (xcd < r ? xcd * (q + 1) : r * (q + 1) + (xcd - r) * q) + off; }
    const int nig = WGM * nN, gid = wgid / nig, fm = gid * WGM, gsz = (nM - fm) < WGM ? (nM - fm) : WGM;
    pm = __builtin_amdgcn_readfirstlane(fm + ((wgid % nig) % gsz)); pn = __builtin_amdgcn_readfirstlane((wgid % nig) / gsz);
}
struct BatchOrder {
    int nM, nN, nz, G, c; const char* A; size_t az, am; const char* B; size_t bz, bn;
    __device__ __forceinline__ bool next(int i, Unit& u) const {
        const int L = i * G + c, per = nM * nN; if (L >= per * nz) return false;
        const int z = L / per; int pm, pn; map_unit(L - z * per, nM, nN, pm, pn);
        u.pm = pm; u.pn = pn; u.z = z; u.A = A + z * az + pm * am; u.B = B + z * bz + pn * bn; return true;
    }
};
struct OrderRKV {
    int G, c; const char* XM; const char* WR; const char* L1T;
    __device__ __forceinline__ bool next(int i, Unit& u) const {
        const int L = i * G + c; if (L >= 960) return false;
        if (L < 768) { const int z = L >> 8, r = L & 255, x = r & 7, y = r >> 3; u.pm = 8 * x + (y >> 2); u.pn = y & 3; u.z = z;
            u.A = XM + ((size_t)z * M + (size_t)u.pm * 256) * (D * 2); u.B = WR + ((size_t)z * D + (size_t)u.pn * 256) * (D * 2); }
        else { const int j = L - 768, q = j >> 6; u.pm = j & 63; u.pn = 0; u.z = 3 + q;
            u.A = XM + ((size_t)(3 + q) * M + (size_t)u.pm * 256) * (D * 2); u.B = L1T + (size_t)q * 256 * (D * 2); }
        return true;
    }
};
struct MoeOrder {
    int G, c, nN; const LAS int* p; const char* A; size_t am; const char* B; size_t be, bn; int lim = 0x7fffffff;
    __device__ __forceinline__ void load(const int* pst, LAS unsigned char* lds) {
        LAS int* t = (LAS int*)(lds + MISC_OFF + 128);
        if (threadIdx.x < 9) t[threadIdx.x] = pst[threadIdx.x] >> 8;
        __syncthreads(); p = t;
    }
    __device__ __forceinline__ bool next(int i, Unit& u) const {
        const int nM = __builtin_amdgcn_readfirstlane(p[8]), L = i * G + c; if (L >= nM * nN || L >= lim) return false;
        int pm, pn; map_unit(L, nM, nN, pm, pn);
        int e = 0;
#pragma unroll
        for (int k = 1; k < 8; ++k) e += (pm >= __builtin_amdgcn_readfirstlane(p[k])) ? 1 : 0;
        u.pm = pm; u.pn = pn; u.z = e; u.A = A + pm * am; u.B = B + e * be + pn * bn; return true;
    }
};

struct MoeTail {
    int c, nN; const LAS int* p; const char* A; size_t am; const char* B; size_t be, bn; int L0, R, S; size_t ksub;
    __device__ __forceinline__ bool next(int i, Unit& u) const {
        if (i > 0 || c >= R * S) return false;
        const int s = c / R, j = c - s * R, nM = __builtin_amdgcn_readfirstlane(p[8]); int pm, pn; map_unit(L0 + j, nM, nN, pm, pn);
        int e = 0;
#pragma unroll
        for (int k = 1; k < 8; ++k) e += (pm >= __builtin_amdgcn_readfirstlane(p[k])) ? 1 : 0;
        u.pm = pm; u.pn = pn; u.z = c; u.A = A + pm * am + s * ksub; u.B = B + e * be + pn * bn + s * ksub; return true;
    }
};

template <class Epi, class Sched>
__device__ __forceinline__ void gemm_simple(const GemmDims g, const Sched& S, const Epi& E) {
    const int tid = threadIdx.x, wid = __builtin_amdgcn_readfirstlane(tid >> 6), lane = tid & 63, wr = wid >> 2, wc = wid & 3, fr = lane & 15, fq = lane >> 4;
    Unit u;
    for (int i = 0; S.next(i, u); ++i) {
        f32x4 acc[2][2][4][2];
#pragma unroll
        for (int a = 0; a < 2; ++a)
#pragma unroll
            for (int b = 0; b < 2; ++b)
#pragma unroll
                for (int m = 0; m < 4; ++m)
#pragma unroll
                    for (int n = 0; n < 2; ++n) acc[a][b][m][n] = (f32x4){0.f, 0.f, 0.f, 0.f};
        const char* pa = u.A + ((size_t)(wr * 64 + fr) * g.lda + fq * 8) * 2;
        const char* pb = u.B + ((size_t)(wc * 32 + fr) * g.ldb + fq * 8) * 2;
#pragma unroll 1
        for (int k0 = 0; k0 < g.K; k0 += 32) {
            bf16x8 af[2][4], bfr[2][2];
#pragma unroll
            for (int ai = 0; ai < 2; ++ai)
#pragma unroll
                for (int m = 0; m < 4; ++m) af[ai][m] = *(const bf16x8*)(pa + ((size_t)(ai * 128 + m * 16) * g.lda + k0) * 2);
#pragma unroll
            for (int bj = 0; bj < 2; ++bj)
#pragma unroll
                for (int n = 0; n < 2; ++n) bfr[bj][n] = *(const bf16x8*)(pb + ((size_t)(bj * 128 + n * 16) * g.ldb + k0) * 2);
#pragma unroll
            for (int ai = 0; ai < 2; ++ai)
#pragma unroll
                for (int bj = 0; bj < 2; ++bj)
#pragma unroll
                    for (int m = 0; m < 4; ++m)
#pragma unroll
                        for (int n = 0; n < 2; ++n) acc[ai][bj][m][n] = __builtin_amdgcn_mfma_f32_16x16x32_bf16(bfr[bj][n], af[ai][m], acc[ai][bj][m][n], 0, 0, 0);
        }
        E(acc, u, wr, wc, fr, fq);
    }
}

__host__ __device__ __forceinline__ int lds_byte(int r, int c) { const int st = (r >> 4) * 2 + (c >> 5), rr = r & 15, cc = c & 31, ob = rr * 64 + cc * 2; return st * 1024 + (ob ^ (((ob >> 9) & 1) << 5)); }
__host__ __device__ __forceinline__ void stage_rc(int b, int& R, int& C) { const int st = b / 1024, sb = b % 1024, swz = sb ^ (((sb >> 9) & 1) << 5); R = (st >> 1) * 16 + swz / 64; C = (st & 1) * 32 + (swz % 64) / 2; }

__device__ __forceinline__ const char* uptr(const char* p) { const unsigned long long v = (unsigned long long)p; const unsigned lo = __builtin_amdgcn_readfirstlane((unsigned)v), hi = __builtin_amdgcn_readfirstlane((unsigned)(v >> 32)); return (const char*)(((unsigned long long)hi << 32) | lo); }
__device__ __forceinline__ void unit_uniform(Unit& u) { u.pm = __builtin_amdgcn_readfirstlane(u.pm); u.pn = __builtin_amdgcn_readfirstlane(u.pn); u.z = __builtin_amdgcn_readfirstlane(u.z); u.A = uptr(u.A); u.B = uptr(u.B); }
typedef int i32x4v __attribute__((ext_vector_type(4)));
typedef int i32x8v __attribute__((ext_vector_type(8)));
__device__ __forceinline__ i32x8v cat8(const bf16x8 lo, const bf16x8 hi) { const i32x4v a = __builtin_bit_cast(i32x4v, lo), b = __builtin_bit_cast(i32x4v, hi); return __builtin_shufflevector(a, b, 0, 1, 2, 3, 4, 5, 6, 7); }
template <class Epi, class Sched, int QM = 0>
__device__ __forceinline__ void gemm_phase(LAS unsigned char* lds, const GemmDims g, const Sched& S, const Epi& E) {
    int tid_ = threadIdx.x; asm volatile("" : "+v"(tid_));
    const int tid = tid_, wid = __builtin_amdgcn_readfirstlane(tid >> 6), lane = tid & 63, wr = wid >> 2, wc = wid & 3, fr = lane & 15, fq = lane >> 4;
    const int nt = g.K / BK;
    unsigned voffA[2], voffB[2];
#pragma unroll
    for (int i = 0; i < 2; ++i) { int R, C; stage_rc(tid * 16 + i * 8192, R, C); voffA[i] = (unsigned)(R * g.lda + C) * 2u; voffB[i] = (unsigned)(R * g.ldb + C) * 2u; }
    const size_t kstep = (size_t)(BK * 2);
    const size_t hstepA = (size_t)HALF * g.lda * 2, hstepB = (size_t)HALF * g.ldb * 2;
    const unsigned ldsw = (unsigned)wid * 1024u;
    const int aoff = lds_byte(wr * 64 + fr, fq * 8), boff = lds_byte(wc * 32 + fr, fq * 8);
#define PG8_SA(b, h) (((b) * 2 + (h)) * HTB)
#define PG8_SB(b, h) ((4 + (b) * 2 + (h)) * HTB)
#define PG8_STAGE(bufoff, gbase, voff) do { _Pragma("unroll") for (int _i = 0; _i < 2; ++_i) \
        __builtin_amdgcn_global_load_lds((const unsigned*)((const char*)(gbase) + (voff)[_i]), (LAS unsigned*)(lds + (bufoff) + ldsw + _i * 8192), 16, 0, 0); } while (0)
#define PG8_LD8(p) __builtin_shufflevector(*(const LAS i32x4v*)(p), *(const LAS i32x4v*)((p) + 1024), 0, 1, 2, 3, 4, 5, 6, 7)
    LAS unsigned char* pA_ = lds + aoff; LAS unsigned char* pB_ = lds + 4 * HTB + boff; asm volatile("" : "+v"(pA_), "+v"(pB_));
#define PG8_LDA(dst, b, h) do { _Pragma("unroll") for (int m = 0; m < 4; ++m) dst[m] = PG8_LD8(pA_ + PG8_SA(b, h) + m * 2048); } while (0)
#define PG8_LDB(dst, b, h) do { _Pragma("unroll") for (int n = 0; n < 2; ++n) dst[n] = PG8_LD8(pB_ + (PG8_SB(b, h) - 4 * HTB) + n * 2048); } while (0)
#define PG8_LO(v) __builtin_bit_cast(bf16x8, __builtin_shufflevector(v, v, 0, 1, 2, 3))
#define PG8_HI(v) __builtin_bit_cast(bf16x8, __builtin_shufflevector(v, v, 4, 5, 6, 7))
#define PG8_MMA(ai, bj, At, Bt) do { __builtin_amdgcn_s_setprio(1); _Pragma("unroll") for (int m = 0; m < 4; ++m) _Pragma("unroll") for (int n = 0; n < 2; ++n) { \
        if constexpr (QM == 1) asm volatile("v_mfma_scale_f32_16x16x128_f8f6f4 %0, %1, %2, %0, %3, %4 op_sel_hi:[0,0,0]" : "+v"(acc[ai][bj][m][n]) : "v"(Bt[n]), "v"(At[m]), "v"(f8_sw), "v"(f8_sa));   \
        else if constexpr (QM == 2) { i32x4v c_ = __builtin_bit_cast(i32x4v, acc[ai][bj][m][n]); c_ = __builtin_amdgcn_mfma_i32_16x16x64_i8(__builtin_shufflevector(Bt[n], Bt[n], 0, 1, 2, 3), __builtin_shufflevector(At[m], At[m], 0, 1, 2, 3), c_, 0, 0, 0); \
            c_ = __builtin_amdgcn_mfma_i32_16x16x64_i8(__builtin_shufflevector(Bt[n], Bt[n], 4, 5, 6, 7), __builtin_shufflevector(At[m], At[m], 4, 5, 6, 7), c_, 0, 0, 0); acc[ai][bj][m][n] = __builtin_bit_cast(f32x4, c_); } \
        else { acc[ai][bj][m][n] = __builtin_amdgcn_mfma_f32_16x16x32_bf16(PG8_LO(Bt[n]), PG8_LO(At[m]), acc[ai][bj][m][n], 0, 0, 0); acc[ai][bj][m][n] = __builtin_amdgcn_mfma_f32_16x16x32_bf16(PG8_HI(Bt[n]), PG8_HI(At[m]), acc[ai][bj][m][n], 0, 0, 0); } } __builtin_amdgcn_s_setprio(0); } while (0)
#define PG8_WAIT_V(n) asm volatile("s_waitcnt vmcnt(" #n ")" ::: "memory")
#define PG8_WAIT_L(n) asm volatile("s_waitcnt lgkmcnt(" #n ")" ::: "memory")
#define PG8_BAR __builtin_amdgcn_s_barrier()
#define PG8_SCHED __builtin_amdgcn_sched_barrier(0)
    Unit cur, nxt; int ui = 0;
    if (!S.next(0, cur)) return;
    unit_uniform(cur);
    f32x4 acc[2][2][4][2];
#pragma unroll
    for (int a = 0; a < 2; ++a)
#pragma unroll
        for (int b = 0; b < 2; ++b)
#pragma unroll
            for (int m = 0; m < 4; ++m)
#pragma unroll
                for (int n = 0; n < 2; ++n) acc[a][b][m][n] = (f32x4){0.f, 0.f, 0.f, 0.f};
    i32x8v At[4], B0[2], B1[2];
    const int f8_sw = 0x79797979, f8_sa = 0x7F7F7F7F;
    const char* cA = cur.A; const char* cB = cur.B;
    PG8_STAGE(PG8_SB(0, 0), cB, voffB); PG8_STAGE(PG8_SB(0, 1), cB + hstepB, voffB); PG8_STAGE(PG8_SA(0, 0), cA, voffA); PG8_STAGE(PG8_SA(0, 1), cA + hstepA, voffA);
    if (wr == 1) PG8_BAR;
    PG8_WAIT_V(2); PG8_BAR;
    PG8_STAGE(PG8_SB(1, 0), cB + kstep, voffB); PG8_STAGE(PG8_SA(1, 0), cA + kstep, voffA); PG8_STAGE(PG8_SB(1, 1), cB + hstepB + kstep, voffB);
    PG8_WAIT_V(6); PG8_BAR;
    for (;;) {
        const bool has_next = S.next(ui + 1, nxt); if (has_next) unit_uniform(nxt);
        const char* nA = has_next ? nxt.A : cA; const char* nB = has_next ? nxt.B : cB;
#pragma unroll 1
        for (int t = 0; t < nt; t += 2) {
            const bool last = (t == nt - 2);
            const char* a1 = cA + (size_t)(t + 1) * kstep;
            const char* a2 = last ? nA : cA + (size_t)(t + 2) * kstep; const char* b2 = last ? nB : cB + (size_t)(t + 2) * kstep;
            const char* a3 = a2 + kstep; const char* b3 = b2 + kstep;
            PG8_LDB(B0, 0, 0); PG8_LDB(B1, 0, 1); PG8_SCHED; PG8_LDA(At, 0, 0); PG8_STAGE(PG8_SA(1, 1), a1 + hstepA, voffA);
            PG8_WAIT_V(8); PG8_WAIT_L(0); PG8_BAR; PG8_MMA(0, 0, At, B0); PG8_MMA(0, 1, At, B1); PG8_BAR; PG8_SCHED;
            PG8_LDA(At, 0, 1); PG8_STAGE(PG8_SB(0, 0), b2, voffB); PG8_STAGE(PG8_SB(0, 1), b2 + hstepB, voffB); PG8_STAGE(PG8_SA(0, 0), a2, voffA);
            PG8_WAIT_V(8); PG8_WAIT_L(0); PG8_BAR; PG8_MMA(1, 0, At, B0); PG8_MMA(1, 1, At, B1); PG8_BAR; PG8_SCHED;
            PG8_LDB(B0, 1, 0); PG8_LDB(B1, 1, 1); PG8_SCHED; PG8_LDA(At, 1, 0); PG8_STAGE(PG8_SA(0, 1), a2 + hstepA, voffA);
            PG8_WAIT_V(8); PG8_WAIT_L(0); PG8_BAR; PG8_MMA(0, 0, At, B0); PG8_MMA(0, 1, At, B1); PG8_BAR; PG8_SCHED;
            PG8_LDA(At, 1, 1); PG8_STAGE(PG8_SB(1, 0), b3, voffB); PG8_STAGE(PG8_SB(1, 1), b3 + hstepB, voffB); PG8_STAGE(PG8_SA(1, 0), a3, voffA);
            PG8_WAIT_V(8); PG8_WAIT_L(0); PG8_BAR; PG8_MMA(1, 0, At, B0); PG8_MMA(1, 1, At, B1); PG8_BAR; PG8_SCHED;
        }
        if (wr == 0) PG8_BAR;
        if constexpr (QM == 1) asm volatile("s_nop 15\n\ts_nop 15\n\ts_nop 15" ::: "memory");
        { int te = threadIdx.x; asm volatile("" : "+v"(te));
          const int le = te & 63, we = __builtin_amdgcn_readfirstlane(te >> 6); E(acc, cur, we >> 2, we & 3, le & 15, le >> 4); }
        if (!has_next) break;
#pragma unroll
        for (int a = 0; a < 2; ++a)
#pragma unroll
            for (int b = 0; b < 2; ++b)
#pragma unroll
                for (int m = 0; m < 4; ++m)
#pragma unroll
                    for (int n = 0; n < 2; ++n) acc[a][b][m][n] = (f32x4){0.f, 0.f, 0.f, 0.f};
        cur = nxt; cA = nA; cB = nB; ++ui;
        if (wr == 1) PG8_BAR;
    }
    PG8_WAIT_V(0);
    PG8_BAR;
#undef PG8_SA
#undef PG8_SB
#undef PG8_STAGE
#undef PG8_LDA
#undef PG8_LDB
#undef PG8_LD8
#undef PG8_LO
#undef PG8_HI
#undef PG8_MMA
#undef PG8_WAIT_V
#undef PG8_WAIT_L
#undef PG8_BAR
#undef PG8_SCHED
}

template <class Epi, class Sched, int QM = 0>
__device__ __forceinline__ void gemm_run(LAS unsigned char* lds, const GemmDims g, const Sched& S, const Epi& E) {
#if FAST_GEMM
    gemm_phase<Epi, Sched, QM>(lds, g, S, E);
#else
    gemm_simple<Epi, Sched>(g, S, E);
#endif
}

#define EPI_ARGS const f32x4 (&acc)[2][2][4][2], const Unit& u, int wr, int wc, int fr, int fq
#define ROWS_LOOP _Pragma("unroll") for (int ai = 0; ai < 2; ++ai) _Pragma("unroll") for (int m = 0; m < 4; ++m)
#define COLS_LOOP _Pragma("unroll") for (int bj = 0; bj < 2; ++bj) _Pragma("unroll") for (int n = 0; n < 2; ++n)
__device__ __forceinline__ void st_bf16x4(bf16* p, const f32x4 v) { u32x2 w; w.x = cvt_pk_bf16(v[0], v[1]); w.y = cvt_pk_bf16(v[2], v[3]); *(u32x2*)p = w; }

__host__ __device__ __forceinline__ int slot32(int c) { return 16 * ((c >> 2) & 1) + 4 * (c >> 3) + (c & 3); }
#define BJ_LOOP _Pragma("unroll") for (int bj = 0; bj < 2; ++bj)
__device__ __forceinline__ void st_bf16x8(bf16* p, const f32x4 a, const f32x4 b) { u32x4 w; w.x = cvt_pk_bf16(a[0], a[1]); w.y = cvt_pk_bf16(a[2], a[3]); w.z = cvt_pk_bf16(b[0], b[1]); w.w = cvt_pk_bf16(b[2], b[3]); *(u32x4*)p = w; }
typedef float f32x2p __attribute__((ext_vector_type(2)));
#define P2LO(v) __builtin_shufflevector(v, v, 0, 1)
#define P2HI(v) __builtin_shufflevector(v, v, 2, 3)
#define P2CAT(a, b) __builtin_shufflevector(a, b, 0, 1, 2, 3)
__device__ __forceinline__ f32x2p exp2_2(const f32x2p t) { f32x2p e; e.x = __builtin_amdgcn_exp2f(t.x); e.y = __builtin_amdgcn_exp2f(t.y); return e; }
__device__ __forceinline__ f32x2p rcp_2(const f32x2p t) { f32x2p e; e.x = __builtin_amdgcn_rcpf(t.x); e.y = __builtin_amdgcn_rcpf(t.y); return e; }
__device__ __forceinline__ f32x2p sigmoid2(const f32x2p x) { return rcp_2(exp2_2(x * -1.4426950408889634f) + 1.0f); }
__device__ __forceinline__ f32x2p tanh2(const f32x2p x) { const f32x2p r = rcp_2(exp2_2(x * 2.8853900817779268f) + 1.0f); return r * -2.0f + 1.0f; }
__device__ __forceinline__ f32x2p gelu2(const f32x2p x) {
    const f32x2p in = x * (x * x * 0.044715f + 1.0f); const f32x2p r = rcp_2(exp2_2(in * (2.0f * 0.7978845608028654f * 1.4426950408889634f)) + 1.0f); return x - x * r; }
__device__ __forceinline__ f32x2p silu_mul2(const f32x2p g, const f32x2p u) { return (g * u) * sigmoid2(g); }
__device__ __forceinline__ f32x4 silu_mul4(const f32x4 g, const f32x4 u) { return P2CAT(silu_mul2(P2LO(g), P2LO(u)), silu_mul2(P2HI(g), P2HI(u))); }
__device__ __forceinline__ f32x4 act4(const f32x4 v, int kind) { f32x4 o = v;
    if (kind == 1) o = P2CAT(tanh2(P2LO(v)), tanh2(P2HI(v)));
    if (kind == 2) o = P2CAT(sigmoid2(P2LO(v)), sigmoid2(P2HI(v)));
    if (kind == 3) o = P2CAT(gelu2(P2LO(v)), gelu2(P2HI(v)));
    return o; }
struct EpiRKV {
    bf16* RKV; bf16* L1O;
    __device__ __forceinline__ void operator()(EPI_ARGS) const {
        const int row0 = u.pm * 256 + wr * 64 + fr, col0 = wc * 32 + fq * 8;
        if (u.z < 3) {
            bf16* base = RKV + ((size_t)u.z * M) * D + u.pn * 256 + col0;
            ROWS_LOOP { bf16* rp = base + (size_t)(row0 + ai * 128 + m * 16) * D; BJ_LOOP st_bf16x8(rp + bj * 128, acc[ai][bj][m][0], acc[ai][bj][m][1]); }
        } else {
            const int q = u.z - 3, kind = (q == 0) ? 1 : ((q == 2) ? 2 : 0); bf16* base = L1O + ((size_t)q * M) * 256 + col0;
            ROWS_LOOP { bf16* rp = base + (size_t)(row0 + ai * 128 + m * 16) * 256; BJ_LOOP st_bf16x8(rp + bj * 128, act4(acc[ai][bj][m][0], kind), act4(acc[ai][bj][m][1], kind)); }
        }
    }
};
struct EpiBf16 {
    bf16* O; size_t zstride; int ldo;
    __device__ __forceinline__ void operator()(EPI_ARGS) const {
        bf16* base = O + u.z * zstride + u.pn * 256 + wc * 32 + fq * 8; const int row0 = u.pm * 256 + wr * 64 + fr;
        ROWS_LOOP { bf16* rp = base + (size_t)(row0 + ai * 128 + m * 16) * ldo; BJ_LOOP st_bf16x8(rp + bj * 128, acc[ai][bj][m][0], acc[ai][bj][m][1]); }
    }
};
struct EpiPart {
    bf16* P;
    __device__ __forceinline__ void operator()(EPI_ARGS) const {
        bf16* base = P + (size_t)u.z * 65536 + wc * 32 + fq * 8; const int row0 = wr * 64 + fr;
        ROWS_LOOP { bf16* rp = base + (row0 + ai * 128 + m * 16) * 256; BJ_LOOP st_bf16x8(rp + bj * 128, acc[ai][bj][m][0], acc[ai][bj][m][1]); }
    }
};
template <class TB, class TO>
struct EpiResT {
    const TB* base; TO* out; const float* gt;
    __device__ __forceinline__ void operator()(EPI_ARGS) const {
        const int row0 = u.pm * 256 + wr * 64 + fr, col0 = u.pn * 256 + wc * 32 + fq * 8; const float* gtb = gt + (size_t)(u.pm >> 4) * MODW + col0;
        f32x4 gv[2][2];
        COLS_LOOP gv[bj][n] = *(const f32x4*)(gtb + bj * 128 + n * 4) + 1.0f;
        ROWS_LOOP { const size_t off = (size_t)(row0 + ai * 128 + m * 16) * D + col0;
            BJ_LOOP { f32x4 o[2];
#pragma unroll
                for (int n = 0; n < 2; ++n) o[n] = ld4any<TB>(base + off + bj * 128 + n * 4, 0) + gv[bj][n] * acc[ai][bj][m][n];
                if constexpr (sizeof(TO) == 2) st_bf16x8((bf16*)(out + off + bj * 128), o[0], o[1]); else { *(f32x4*)(out + off + bj * 128) = o[0]; *(f32x4*)(out + off + bj * 128 + 4) = o[1]; } }
            asm volatile("" ::: "memory"); }
    }
};
typedef EpiResT<float, float> EpiRes;
struct EpiGU {
    bf16* ACT;
    __device__ __forceinline__ void operator()(EPI_ARGS) const {
        const int row0 = u.pm * 256 + wr * 64 + fr; bf16* base = ACT + u.pn * 128 + wc * 32 + fq * 8;
        ROWS_LOOP { f32x4 v[2];
#pragma unroll
            for (int n = 0; n < 2; ++n) { const f32x4 gq = acc[ai][0][m][n], uq = acc[ai][1][m][n]; v[n][0] = siluf_(gq[0]) * uq[0]; v[n][1] = siluf_(gq[1]) * uq[1]; v[n][2] = siluf_(gq[2]) * uq[2]; v[n][3] = siluf_(gq[3]) * uq[3]; }
            st_bf16x8(base + (size_t)(row0 + ai * 128 + m * 16) * FF, v[0], v[1]); }
    }
};
struct EpiGUi8 {
    bf16* ACT; const float* SA; const unsigned* amax;
    __device__ __forceinline__ void operator()(EPI_ARGS) const {
        const int row0 = u.pm * 256 + wr * 64 + fr; bf16* base = ACT + u.pn * 128 + wc * 32 + fq * 8; const float sw = __uint_as_float(*amax) * (1.0f / 127.0f);
        ROWS_LOOP { const int row = row0 + ai * 128 + m * 16; const float sc = SA[row] * sw; f32x4 v[2];
#pragma unroll
            for (int n = 0; n < 2; ++n) { const i32x4v gi = __builtin_bit_cast(i32x4v, acc[ai][0][m][n]), ui = __builtin_bit_cast(i32x4v, acc[ai][1][m][n]);
                const f32x4 gf = (f32x4){(float)gi[0], (float)gi[1], (float)gi[2], (float)gi[3]} * sc, uf = (f32x4){(float)ui[0], (float)ui[1], (float)ui[2], (float)ui[3]} * sc; v[n] = silu_mul4(gf, uf); }
            st_bf16x8(base + (size_t)row * FF, v[0], v[1]); }
    }
};
struct EpiGU8 {
    unsigned char* ACT;
    __device__ __forceinline__ void operator()(EPI_ARGS) const {
        const int row0 = u.pm * 256 + wr * 64 + fr; unsigned char* base = ACT + u.pn * 128 + wc * 32 + fq * 8;
        ROWS_LOOP { u32x2 w;
            { const f32x4 v = silu_mul4(acc[ai][0][m][0], acc[ai][1][m][0]); w.x = pk_fp8x4(v[0], v[1], v[2], v[3]); }
            { const f32x4 v = silu_mul4(acc[ai][0][m][1], acc[ai][1][m][1]); w.y = pk_fp8x4(v[0], v[1], v[2], v[3]); }
            *(u32x2*)(base + (size_t)(row0 + ai * 128 + m * 16) * FF) = w; }
    }
};
struct EpiWin {
    bf16* XB; bf16* GATE;
    __device__ __forceinline__ void operator()(EPI_ARGS) const {
        const int row0 = u.pm * 256 + wr * 64 + fr; const bool isg = u.pn >= 4; const int kind = isg ? 3 : 0; bf16* base = (isg ? GATE : XB) + (u.pn & 3) * 256 + wc * 32 + fq * 8;
        ROWS_LOOP { bf16* rp = base + (size_t)(row0 + ai * 128 + m * 16) * D; BJ_LOOP st_bf16x8(rp + bj * 128, act4(acc[ai][bj][m][0], kind), act4(acc[ai][bj][m][1], kind)); }
    }
};
struct EpiGates {
    const float* bg; const float* lam; const bf16* XBC; bf16* AT; bf16* BT;
    __device__ __forceinline__ void operator()(EPI_ARGS) const {
        const int row0 = u.pm * 256 + wr * 64 + fr, j0 = wc * 32 + fq * 8, ch0 = 256 * u.z + 128 * u.pn + j0;
        f32x4 br[2], bi[2], sp[2];
#pragma unroll
        for (int n = 0; n < 2; ++n) { br[n] = *(const f32x4*)(bg + u.z * 512 + 128 * u.pn + j0 + n * 4); bi[n] = *(const f32x4*)(bg + u.z * 512 + 256 + 128 * u.pn + j0 + n * 4);
            const f32x4 l = *(const f32x4*)(lam + ch0 + n * 4); sp[n][0] = -8.0f * softplusf_(-l[0]); sp[n][1] = -8.0f * softplusf_(-l[1]); sp[n][2] = -8.0f * softplusf_(-l[2]); sp[n][3] = -8.0f * softplusf_(-l[3]); }
        ROWS_LOOP { const size_t off = (size_t)(row0 + ai * 128 + m * 16) * D + ch0; const u32x4 xw = *(const u32x4*)(XBC + off); float xv[8]; unpack8(xw, xv);
            f32x4 av[2], bv[2];
#pragma unroll
            for (int n = 0; n < 2; ++n) { const f32x4 rq = acc[ai][0][m][n] + br[n], iq = acc[ai][1][m][n] + bi[n];
#pragma unroll
                for (int h = 0; h < 2; ++h) { const f32x2p rr = sigmoid2(h ? P2HI(rq) : P2LO(rq)), ig = sigmoid2(h ? P2HI(iq) : P2LO(iq)), sp2 = h ? P2HI(sp[n]) : P2LO(sp[n]), xx = (f32x2p){xv[4 * n + 2 * h], xv[4 * n + 2 * h + 1]};
                    const f32x2p la = rr * sp2; const f32x2p om = exp2_2(la * (2.0f * 1.4426950408889634f)) * -1.0f + 1.0f; const f32x2p gx = ig * xx;
                    av[n][2 * h] = la.x; av[n][2 * h + 1] = la.y; bv[n][2 * h] = __builtin_amdgcn_sqrtf(fmaxf(om.x, 0.f)) * gx.x; bv[n][2 * h + 1] = __builtin_amdgcn_sqrtf(fmaxf(om.y, 0.f)) * gx.y; } }
            st_bf16x8(AT + off, av[0], av[1]); st_bf16x8(BT + off, bv[0], bv[1]); }
    }
};
#define XB_TMO      128
#define XB_XCNT(j)  (256  + 64 * (j))
#define XB_XSUB(j)  (1280 + 64 * (j))
#define XB_XGEN(j)  (2304 + 64 * (j))
#define XB_TOP      3328
#define XB_TOPGEN   3392
#define XCD_BAR_WORDS 3456
#define XB_SPIN_CAP (1u << 18)
__device__ __forceinline__ unsigned xb_ld(unsigned* p)              { return __hip_atomic_load(p, __ATOMIC_RELAXED, __HIP_MEMORY_SCOPE_AGENT); }
__device__ __forceinline__ unsigned xb_add(unsigned* p, unsigned v) { return __hip_atomic_fetch_add(p, v, __ATOMIC_RELAXED, __HIP_MEMORY_SCOPE_AGENT); }
__device__ __forceinline__ unsigned xb_xcc_id() { return (unsigned)__builtin_amdgcn_s_getreg((3 << 11) | 20) & 0xFu; }
#define XB_SPIN(cond, bar) do { unsigned _sp = 0; while (cond) { __builtin_amdgcn_s_sleep(1); \
    if ((++_sp & 255u) == 0u) { if (xb_ld(&(bar)[XB_TMO])) break; if (_sp > XB_SPIN_CAP) { atomicAdd(&(bar)[XB_TMO], 1u); break; } } } } while (0)
struct XcdBarrier { unsigned* bar; unsigned x; volatile LAS unsigned* st; };
__device__ __forceinline__ XcdBarrier xcd_barrier_post(unsigned* bar, volatile LAS unsigned* st) {
    XcdBarrier b; b.bar = bar; b.x = xb_xcc_id(); b.st = st;
    if (threadIdx.x == 0) (void)xb_add(&bar[XB_XCNT(b.x)], 1u);
    return b;
}
__device__ __forceinline__ void xcd_barrier_complete(unsigned* bar, unsigned x, unsigned& nloc, unsigned& nx) {
    const unsigned G = gridDim.x * gridDim.y * gridDim.z;
    unsigned sum, cnt, mine, sp = 0u;
    for (;;) {
        sum = 0u; cnt = 0u; mine = 0u;
#pragma unroll
        for (unsigned j = 0; j < 16; ++j) { const unsigned c = xb_ld(&bar[XB_XCNT(j)]); sum += c; cnt += (c > 0u) ? 1u : 0u; mine = (j == x) ? c : mine; }
        if (sum == G) break;
        __builtin_amdgcn_s_sleep(1);
        if ((++sp & 255u) == 0u) { if (xb_ld(&bar[XB_TMO])) break; if (sp > XB_SPIN_CAP) { atomicAdd(&bar[XB_TMO], 1u); break; } }
    }
    nloc = mine > 0u ? mine : 1u; nx = cnt > 0u ? cnt : 1u;
}
__device__ __forceinline__ void xcd_barrier(const XcdBarrier& b) {
    asm volatile("s_waitcnt vmcnt(0)" ::: "memory");
    __syncthreads();
    if (threadIdx.x == 0) {
        unsigned* bar = b.bar;
        __builtin_amdgcn_s_waitcnt(0);
        unsigned nloc = b.st[0], nx = b.st[1];
        if (nloc == 0u) { xcd_barrier_complete(bar, b.x, nloc, nx); b.st[0] = nloc; b.st[1] = nx; }
        const unsigned old = xb_add(&bar[XB_XSUB(b.x)], 1u);
        const unsigned gen = old / nloc;
        if (old + 1u == (gen + 1u) * nloc) {
            __builtin_amdgcn_fence(__ATOMIC_RELEASE, "agent");
            asm volatile("s_waitcnt vmcnt(0)" ::: "memory");
            const unsigned og = xb_add(&bar[XB_TOP], 1u);
            const unsigned tg = og / nx;
            if (og + 1u == (tg + 1u) * nx) xb_add(&bar[XB_TOPGEN], 1u);
            else XB_SPIN(xb_ld(&bar[XB_TOPGEN]) == tg, bar);
            __builtin_amdgcn_fence(__ATOMIC_ACQUIRE, "agent");
            xb_add(&bar[XB_XGEN(b.x)], 1u);
            asm volatile("s_waitcnt vmcnt(0)" ::: "memory");
        } else {
            XB_SPIN(xb_ld(&bar[XB_XGEN(b.x)]) == gen, bar);
            __builtin_amdgcn_fence(__ATOMIC_ACQUIRE, "agent");
            asm volatile("s_waitcnt vmcnt(0)" ::: "memory");
        }
    }
    __syncthreads();
}
struct Frame { LAS unsigned char* lds; int tid, lane, wave, G, bid; };
#define WSP(T_, off) ((T_*)(a.ws + (off)))

struct Mat { const float* W; int ldw, Ks, Ns; bf16* WT; int Kd, Nd, mode, half, f8; const unsigned* amax; };
constexpr int CONV_SCR = 16896;
__device__ __forceinline__ void conv_item(const Mat& mt, int item, LAS float* scr, int lane) {
    const int nblk = mt.Nd / 64, kb = item / nblk, nb = item % nblk, k0 = 64 * kb, n0 = 64 * nb;
    const int kq = lane >> 4, c4 = (lane & 15) * 4, n = n0 + c4; const bool nok = n < mt.Ns;
    f32x4 v[16];
#pragma unroll
    for (int j = 0; j < 16; ++j) { const int k = k0 + 4 * j + kq; v[j] = (f32x4){0.f, 0.f, 0.f, 0.f}; if (nok && k < mt.Ks) v[j] = __builtin_nontemporal_load((const f32x4*)(mt.W + (size_t)k * mt.ldw + n)); }
#pragma unroll
    for (int j = 0; j < 16; ++j) { LAS float* d = scr + (4 * j + kq) * 65 + c4; d[0] = v[j][0]; d[1] = v[j][1]; d[2] = v[j][2]; d[3] = v[j][3]; }
    asm volatile("s_waitcnt lgkmcnt(0)" ::: "memory");
    int r0 = n0;
    if (mt.mode == 1) r0 = (n0 < mt.half) ? ((n0 / 128) * 256 + (n0 % 128)) : (((n0 - mt.half) / 128) * 256 + 128 + ((n0 - mt.half) % 128));
    const int nl = lane >> 3, kc = lane & 7;
#pragma unroll
    for (int q = 0; q < 8; ++q) { const int nc = 8 * q + nl, nn = (nc & 32) + slot32(nc & 31); const LAS float* sp = scr + (8 * kc) * 65 + nc;
        if (mt.f8 == 2) { const float sc = 127.0f / fmaxf(__uint_as_float(*mt.amax), 1e-30f); unsigned b[8];
#pragma unroll
            for (int e = 0; e < 8; ++e) { const int qi = (int)__builtin_rintf(fminf(fmaxf(sp[e * 65] * sc, -127.f), 127.f)); b[e] = (unsigned)qi & 0xffu; }
            u32x2 o8; o8.x = b[0] | (b[1] << 8) | (b[2] << 16) | (b[3] << 24); o8.y = b[4] | (b[5] << 8) | (b[6] << 16) | (b[7] << 24);
            *(u32x2*)((unsigned char*)mt.WT + (size_t)(r0 + nn) * mt.Kd + k0 + 8 * kc) = o8; continue; }
        if (mt.f8) { u32x2 o8; o8.x = pk_fp8x4(sp[0 * 65] * F8_WSCALE, sp[1 * 65] * F8_WSCALE, sp[2 * 65] * F8_WSCALE, sp[3 * 65] * F8_WSCALE); o8.y = pk_fp8x4(sp[4 * 65] * F8_WSCALE, sp[5 * 65] * F8_WSCALE, sp[6 * 65] * F8_WSCALE, sp[7 * 65] * F8_WSCALE);
            __builtin_nontemporal_store(o8, (u32x2*)((unsigned char*)mt.WT + (size_t)(r0 + nn) * mt.Kd + k0 + 8 * kc)); continue; }
        u32x4 o; o.x = cvt_pk_bf16(sp[0 * 65], sp[1 * 65]); o.y = cvt_pk_bf16(sp[2 * 65], sp[3 * 65]); o.z = cvt_pk_bf16(sp[4 * 65], sp[5 * 65]); o.w = cvt_pk_bf16(sp[6 * 65], sp[7 * 65]);
        *(u32x4*)(mt.WT + (size_t)(r0 + nn) * mt.Kd + k0 + 8 * kc) = o; }
    asm volatile("s_waitcnt lgkmcnt(0)" ::: "memory");
}
constexpr int CI_RKV = 256, CI_L1 = 64, CI_L2 = 64, CI_SQ = 256, CI_GU = 1792, CI_D = 896, CI_WIN = 512, CI_GT = 32;
constexpr int MOE_CONV_ITEMS = 8 * CI_GU + 8 * CI_D;
constexpr int B_CONV_ITEMS = MOE_CONV_ITEMS + (FFN_I8 ? CI_GU : 0);
constexpr int CONV_ITEMS = 3 * CI_RKV + 3 * CI_L1 + 3 * CI_L2 + CI_SQ + CI_GU + CI_D + CI_WIN + 4 * CI_GT + CI_SQ + 8 * CI_GU + 8 * CI_D;
__device__ __forceinline__ void conv_dispatch(const Args& a, int it, LAS float* scr, int lane) {
    Mat mt;
    if (it < 8 * CI_GU) { const int e = it / CI_GU; mt = Mat{a.in[I_MGU] + (size_t)e * D * 2 * FF, 2 * FF, D, 2 * FF, MOE_FP8 ? (bf16*)(a.ws + WS_MGU + (size_t)e * 2 * FF * D) : WSP(bf16, WS_MGU) + (size_t)e * 2 * FF * D, D, 2 * FF, 1, FF, MOE_FP8, nullptr}; conv_item(mt, it - e * CI_GU, scr, lane); return; } it -= 8 * CI_GU;
    if (it < 8 * CI_D) { const int e = it / CI_D; mt = Mat{a.in[I_MD] + (size_t)e * FF * D, D, FF, D, MOE_FP8 ? (bf16*)(a.ws + WS_MD + (size_t)e * D * FF) : WSP(bf16, WS_MD) + (size_t)e * D * FF, FF, D, 0, 0, MOE_FP8, nullptr}; conv_item(mt, it - e * CI_D, scr, lane); return; } it -= 8 * CI_D;
    if (it < CI_GU) { mt = Mat{a.in[I_FGU], 2 * FF, D, 2 * FF, WSP(bf16, WS_WGU), D, 2 * FF, 1, FF, FFN_I8 ? 2 : FFN_FP8, (const unsigned*)(a.ws + WS_AMAX)}; conv_item(mt, it, scr, lane); return; } it -= CI_GU;
    if (it < CI_D) { mt = Mat{a.in[I_FD], D, FF, D, WSP(bf16, WS_WD), FF, D, 0, 0, FFN_FP8, nullptr}; conv_item(mt, it, scr, lane); return; } it -= CI_D;
    if (it < 3 * CI_RKV) { const int z = it / CI_RKV; mt = Mat{a.in[I_WRKV] + (size_t)z * D * D, D, D, D, WSP(bf16, WS_WRKV) + (size_t)z * D * D, D, D, 0, 0, 0, nullptr}; conv_item(mt, it - z * CI_RKV, scr, lane); return; } it -= 3 * CI_RKV;
    if (it < 3 * CI_L1) { const int q = it / CI_L1; const int rk = q == 2 ? 160 : 64; mt = Mat{a.in[q == 0 ? I_W1 : (q == 1 ? I_A1 : I_G1)], rk, D, rk, WSP(bf16, WS_L1T) + (size_t)q * 256 * D, D, 256, 0, 0, 0, nullptr}; conv_item(mt, it - q * CI_L1, scr, lane); return; } it -= 3 * CI_L1;
    if (it < 3 * CI_L2) { const int q = it / CI_L2; const int rk = q == 2 ? 160 : 64; mt = Mat{a.in[q == 0 ? I_W2 : (q == 1 ? I_A2 : I_G2)], D, rk, D, WSP(bf16, WS_L2T) + (size_t)q * D * 256, 256, D, 0, 0, 0, nullptr}; conv_item(mt, it - q * CI_L2, scr, lane); return; } it -= 3 * CI_L2;
    if (it < CI_SQ) { mt = Mat{a.in[I_WO], D, D, D, WSP(bf16, WS_WO), D, D, 0, 0, 0, nullptr}; conv_item(mt, it, scr, lane); return; } it -= CI_SQ;
    if (it < CI_WIN) { mt = Mat{a.in[I_WIN], 2 * D, D, 2 * D, WSP(bf16, WS_WIN), D, 2 * D, 0, 0, 0, nullptr}; conv_item(mt, it, scr, lane); return; } it -= CI_WIN;
    if (it < 4 * CI_GT) { const int z = it / CI_GT; mt = Mat{a.in[I_WGATES] + (size_t)z * 256 * 512, 512, 256, 512, WSP(bf16, WS_WG) + (size_t)z * 512 * 256, 256, 512, 1, 256, 0, nullptr}; conv_item(mt, it - z * CI_GT, scr, lane); return; } it -= 4 * CI_GT;
    mt = Mat{a.in[I_WOUT], D, D, D, WSP(bf16, WS_WOUT), D, D, 0, 0, 0, nullptr}; conv_item(mt, it, scr, lane);
}
__device__ __forceinline__ void ph_prologue(const Args& a, const Frame& F) {
    LAS float* cond = (LAS float*)F.lds; LAS float* red = cond + 4096;
    for (int g = F.bid; g < 192; g += F.G) {
        for (int i = F.tid; i < 4096; i += NTHR) cond[i] = siluf_(a.in[I_C][i]);
        __syncthreads();
        const int l = g / 96, col0 = (g % 96) * 64, c4 = (F.tid & 15) * 4, kr = F.tid >> 4;
        const float* W = a.in[I_ADAW] + (size_t)l * D * MODW + col0 + c4;
        f32x4 s0 = {0.f, 0.f, 0.f, 0.f}, s1 = s0, s2 = s0, s3 = s0;
#pragma unroll 8
        for (int k = kr; k < D; k += 32) { const f32x4 wv = __builtin_nontemporal_load((const f32x4*)(W + (size_t)k * MODW)); s0 += wv * cond[k]; s1 += wv * cond[1024 + k]; s2 += wv * cond[2048 + k]; s3 += wv * cond[3072 + k]; }
        *(LAS f32x4*)(red + (kr * 4 + 0) * 64 + c4) = s0; *(LAS f32x4*)(red + (kr * 4 + 1) * 64 + c4) = s1; *(LAS f32x4*)(red + (kr * 4 + 2) * 64 + c4) = s2; *(LAS f32x4*)(red + (kr * 4 + 3) * 64 + c4) = s3;
        __syncthreads();
        if (F.tid < 256) { const int b = F.tid >> 6, col = F.tid & 63; float s = 0.f;
#pragma unroll
            for (int q = 0; q < 32; ++q) s += red[(q * 4 + b) * 64 + col];
            WSP(float, WS_MOD)[(size_t)(l * 4 + b) * MODW + col0 + col] = s + a.in[I_ADAB][l * MODW + col0 + col]; }
        __syncthreads();
    }
#if FFN_I8
    { const f32x4* W4 = (const f32x4*)a.in[I_FGU]; float mx = 0.f;
      for (size_t i = (size_t)F.bid * NTHR + F.tid; i < (size_t)D * 2 * FF / 4; i += (size_t)F.G * NTHR) { const f32x4 w4 = W4[i]; mx = fmaxf(mx, fmaxf(fmaxf(fabsf(w4[0]), fabsf(w4[1])), fmaxf(fabsf(w4[2]), fabsf(w4[3])))); }
#pragma unroll
      for (int o = 1; o < 64; o <<= 1) mx = fmaxf(mx, __shfl_xor(mx, o));
      if (F.lane == 0) atomicMax((unsigned*)(a.ws + WS_AMAX), __float_as_uint(mx)); }
#endif
    LAS float* scr = (LAS float*)(F.lds + F.wave * CONV_SCR);
    const int gw = F.bid * NWAVES + F.wave, NGW = F.G * NWAVES;
    for (int it = B_CONV_ITEMS + gw; it < CONV_ITEMS; it += NGW) conv_dispatch(a, it, scr, F.lane);
}

__device__ __forceinline__ void load_gm_sh(const float* g, const float* sh, const float* sc, int lane, f32x4 (&gm)[4], f32x4 (&shv)[4]) {
#pragma unroll
    for (int j = 0; j < 4; ++j) { const f32x4 gv = ((const f32x4*)g)[lane + 64 * j], sv = ((const f32x4*)sc)[lane + 64 * j]; gm[j] = gv * (sv + 1.0f); shv[j] = ((const f32x4*)sh)[lane + 64 * j]; }
}
template <class TX>
__device__ __forceinline__ void mod_row(const TX* xrow, const f32x4 (&gm)[4], const f32x4 (&shv)[4], int lane, f32x4 (&h)[4]) {
    f32x4 v[4]; float ss = 0.f;
#pragma unroll
    for (int j = 0; j < 4; ++j) { v[j] = ld4any<TX>(xrow, lane + 64 * j); ss += (v[j][0] * v[j][0] + v[j][1] * v[j][1]) + (v[j][2] * v[j][2] + v[j][3] * v[j][3]); }
    ss = wave_sum(ss); const float r = 1.0f / sqrtf(ss * (1.0f / D) + 1e-6f);
#pragma unroll
    for (int j = 0; j < 4; ++j) h[j] = (v[j] * r) * gm[j] + shv[j];
}
__device__ __forceinline__ void store_row_bf16(bf16* orow, const f32x4 (&h)[4], int lane) {
#pragma unroll
    for (int j = 0; j < 4; ++j) st_bf16x4(orow + 4 * lane + 256 * j, h[j]);
}

__device__ __forceinline__ void ph_shift(const Args& a, const Frame& F) {
    const float* x = a.in[I_X]; const float* mod = WSP(float, WS_MOD); bf16* XM = WSP(bf16, A_XM);
    const int gw = F.bid * NWAVES + F.wave, NGW = F.G * NWAVES;
    f32x4 mu[6][4];
#pragma unroll
    for (int p = 0; p < 6; ++p)
#pragma unroll
        for (int j = 0; j < 4; ++j) mu[p][j] = ((const f32x4*)(a.in[I_MU] + p * D))[F.lane + 64 * j];
    for (int rb = gw; rb < M / 8; rb += NGW) {
        const int r0 = rb * 8, b = r0 >> 12; const float* mb = mod + (size_t)(0 * 4 + b) * MODW;
        f32x4 gm[4], shv[4], hp[4], h[4];
        load_gm_sh(a.in[I_NORMG] + 0 * 2 * D + 0 * D, mb + 0, mb + 1024, F.lane, gm, shv);
        if ((r0 & (T - 1)) == 0) {
#pragma unroll
            for (int j = 0; j < 4; ++j) hp[j] = (f32x4){0.f, 0.f, 0.f, 0.f};
        } else mod_row(x + (size_t)(r0 - 1) * D, gm, shv, F.lane, hp);
        for (int r = 0; r < 8; ++r) {
            const int row = r0 + r; mod_row(x + (size_t)row * D, gm, shv, F.lane, h);
#pragma unroll
            for (int p = 0; p < 6; ++p) { f32x4 o[4];
#pragma unroll
                for (int j = 0; j < 4; ++j) o[j] = h[j] + (hp[j] - h[j]) * mu[p][j];
                store_row_bf16(XM + ((size_t)p * M + row) * D, o, F.lane); }
#pragma unroll
            for (int j = 0; j < 4; ++j) hp[j] = h[j];
        }
    }
}
__device__ __forceinline__ void ph_modulate(const Args& a, const Frame& F, int l, int s, int f8out = 0) {
    const xres_t* X = XRES(a); const float* mod = WSP(float, WS_MOD); bf16* H = WSP(bf16, A_H);
    const int gw = F.bid * NWAVES + F.wave, NGW = F.G * NWAVES;
    for (int rb = gw; rb < M / 8; rb += NGW) {
        const int r0 = rb * 8, b = r0 >> 12; const float* mb = mod + (size_t)(l * 4 + b) * MODW + s * 3072;
        f32x4 gm[4], shv[4], h[4];
        load_gm_sh(a.in[I_NORMG] + (l * 2 + s) * D, mb + 0, mb + 1024, F.lane, gm, shv);
#pragma unroll 1
        for (int rh = 0; rh < 8; rh += 4) {
        u32x2 raw[4][4];
#pragma unroll
        for (int r = 0; r < 4; ++r)
#pragma unroll
            for (int j = 0; j < 4; ++j) raw[r][j] = ((const u32x2*)(X + (size_t)(r0 + rh + r) * D))[F.lane + 64 * j];
#pragma unroll
        for (int rr_ = 0; rr_ < 4; ++rr_) { const int r = rh + rr_;
            { f32x4 v[4]; float ss = 0.f;
#pragma unroll
              for (int j = 0; j < 4; ++j) { v[j] = unpk4(raw[rr_][j]); ss += (v[j][0] * v[j][0] + v[j][1] * v[j][1]) + (v[j][2] * v[j][2] + v[j][3] * v[j][3]); }
              ss = wave_sum(ss); const float rs = 1.0f / sqrtf(ss * (1.0f / D) + 1e-6f);
#pragma unroll
              for (int j = 0; j < 4; ++j) h[j] = (v[j] * rs) * gm[j] + shv[j]; }
            if (f8out == 2) { unsigned char* h8 = (unsigned char*)H + (size_t)(r0 + r) * D; float mx = 0.f;
#pragma unroll
                for (int j = 0; j < 4; ++j) mx = fmaxf(mx, fmaxf(fmaxf(fabsf(h[j][0]), fabsf(h[j][1])), fmaxf(fabsf(h[j][2]), fabsf(h[j][3]))));
                mx = wave_max(mx);
                mx = fmaxf(mx, 1e-20f); const float inv = 127.0f / mx;
#pragma unroll
                for (int j = 0; j < 4; ++j) { unsigned b[4];
#pragma unroll
                    for (int e = 0; e < 4; ++e) b[e] = (unsigned)(int)__builtin_rintf(h[j][e] * inv) & 0xffu;
                    *(unsigned*)(h8 + 4 * F.lane + 256 * j) = b[0] | (b[1] << 8) | (b[2] << 16) | (b[3] << 24); }
                if (F.lane == 0) WSP(float, WS_SA)[r0 + r] = mx * (1.0f / 127.0f); }
            else if (f8out) { unsigned char* h8 = (unsigned char*)H + (size_t)(r0 + r) * D;
#pragma unroll
                for (int j = 0; j < 4; ++j) *(unsigned*)(h8 + 4 * F.lane + 256 * j) = pk_fp8x4(h[j][0], h[j][1], h[j][2], h[j][3]); }
            else store_row_bf16(H + (size_t)(r0 + r) * D, h, F.lane); } }
    }
}


constexpr size_t A_QG = WS_ARENA, A_Y0G = WS_ARENA + 32 * MiB, A_GG = WS_ARENA + 64 * MiB, A_CTG = WS_ARENA + 96 * MiB, A_H0G = WS_ARENA + 160 * MiB;
constexpr int WK_TC = 32, WK_SF = 5 * 64 + 16;
__device__ __forceinline__ float dpp_f(float x, const int ctrl_sel) {
    const int xi = __builtin_bit_cast(int, x); int r;
    if (ctrl_sel == 0) r = __builtin_amdgcn_update_dpp(0, xi, 0xB1, 0xF, 0xF, true);
    else if (ctrl_sel == 1) r = __builtin_amdgcn_update_dpp(0, xi, 0x4E, 0xF, 0xF, true);
    else if (ctrl_sel == 2) r = __builtin_amdgcn_update_dpp(0, xi, 0x141, 0xF, 0xF, true);
    else r = __builtin_amdgcn_update_dpp(0, xi, 0x140, 0xF, 0xF, true);
    return __builtin_bit_cast(float, r);
}
__device__ __forceinline__ float red16(float x) { x += dpp_f(x, 0); x += dpp_f(x, 1); x += dpp_f(x, 2); x += dpp_f(x, 3); return x; }
__device__ __forceinline__ void wkv_stage_chunk(const Args& a, LAS float* buf, int lt, int lane, int rowc, int c0, int q, const float (&w0)[4], const float (&a0)[4], const float (&kkw)[4], const float (&kaw)[4]) {
    const bf16* RKV = WSP(bf16, A_RKV); const bf16* L2O = WSP(bf16, A_L2O);
    const int lw = lt >> 6, tsub = lane >> 4, j4 = (lane & 15) * 4;
#pragma unroll
    for (int p = 0; p < 2; ++p) {
        const int tl = p * 16 + lw * 4 + tsub; const size_t off = (size_t)(rowc + tl) * D + c0 + j4;
        const u32x2 rw = *(const u32x2*)(RKV + off), kw = *(const u32x2*)(RKV + (size_t)M * D + off), lww = *(const u32x2*)(L2O + off), law = *(const u32x2*)(L2O + (size_t)M * D + off);
        const float rr[4] = {bf2f(rw.x & 0xffffu), __uint_as_float(rw.x & 0xffff0000u), bf2f(rw.y & 0xffffu), __uint_as_float(rw.y & 0xffff0000u)};
        const float kx[4] = {bf2f(kw.x & 0xffffu), __uint_as_float(kw.x & 0xffff0000u), bf2f(kw.y & 0xffffu), __uint_as_float(kw.y & 0xffff0000u)};
        const float lwv[4] = {bf2f(lww.x & 0xffffu), __uint_as_float(lww.x & 0xffff0000u), bf2f(lww.y & 0xffffu), __uint_as_float(lww.y & 0xffff0000u)};
        const float lav[4] = {bf2f(law.x & 0xffffu), __uint_as_float(law.x & 0xffff0000u), bf2f(law.y & 0xffffu), __uint_as_float(law.y & 0xffff0000u)};
        float dec[4], av[4], kk[4], ss = 0.f;
#pragma unroll
        for (int e = 0; e < 4; ++e) { const float wl = -softplusf_(-(w0[e] + lwv[e])) - 0.5f; dec[e] = __expf(-__expf(wl)); av[e] = sigmoidf_(a0[e] + lav[e]); kk[e] = kx[e] * kkw[e]; ss += kk[e] * kk[e]; }
        ss += __shfl_xor(ss, 1); ss += __shfl_xor(ss, 2); ss += __shfl_xor(ss, 4); ss += __shfl_xor(ss, 8);
        const float inv = 1.0f / fmaxf(sqrtf(ss), 1e-12f);
        f32x4 vr, vw, vk, va, vb;
#pragma unroll
        for (int e = 0; e < 4; ++e) { const float kn = kk[e] * inv; vr[e] = rr[e]; vw[e] = dec[e]; vk[e] = kx[e] * (1.0f + (av[e] - 1.0f) * kaw[e]); va[e] = -kn; vb[e] = kn * av[e]; }
        LAS float* dst = buf + tl * WK_SF + j4;
        *(LAS f32x4*)(dst) = vr; *(LAS f32x4*)(dst + 64) = vw; *(LAS f32x4*)(dst + 128) = vk; *(LAS f32x4*)(dst + 192) = va; *(LAS f32x4*)(dst + 256) = vb;
    }
    { const int tl = lt >> 3, i2 = (lt & 7) * 2; const unsigned vw2 = *(const unsigned*)(RKV + (size_t)2 * M * D + (size_t)(rowc + tl) * D + c0 + 16 * q + i2);
      buf[tl * WK_SF + 320 + i2] = bf2f(vw2 & 0xffffu); buf[tl * WK_SF + 320 + i2 + 1] = __uint_as_float(vw2 & 0xffff0000u); }
}
__device__ __forceinline__ void ph_wkv(const Args& a, const Frame& F) {
    float* Y = WSP(float, A_Y);
    LAS float* bufs = (LAS float*)F.lds;
    for (int task = F.bid; task < NB * NH * 4; task += F.G) {
        const int bh = task >> 2, q = task & 3, b = bh >> 4, hd = bh & 15, c0 = hd * 64, row0 = b * T;
        const bool loader = F.wave >= 4; const int lt = F.tid - 256;
        float w0[4], a0[4], kkw[4], kaw[4];
        { const int j4 = (F.lane & 15) * 4;
#pragma unroll
          for (int e = 0; e < 4; ++e) { w0[e] = a.in[I_W0][c0 + j4 + e]; a0[e] = a.in[I_A0][c0 + j4 + e]; kkw[e] = a.in[I_KK][c0 + j4 + e]; kaw[e] = a.in[I_KA][c0 + j4 + e]; } }
        if (loader) wkv_stage_chunk(a, bufs, lt, F.lane, row0, c0, q, w0, a0, kkw, kaw);
        __syncthreads();
        const int rloc = F.wave * 4 + (F.lane >> 4), k4 = (F.lane & 15) * 4;
        float S0 = 0.f, S1 = 0.f, S2 = 0.f, S3 = 0.f;
        for (int ch = 0; ch < T / WK_TC; ++ch) {
            LAS float* cur = bufs + (ch & 1) * (WK_TC * WK_SF);
            if (loader) { if (ch + 1 < T / WK_TC) wkv_stage_chunk(a, bufs + ((ch + 1) & 1) * (WK_TC * WK_SF), lt, F.lane, row0 + (ch + 1) * WK_TC, c0, q, w0, a0, kkw, kaw); }
            else {
                float* yp = Y + (size_t)(row0 + ch * WK_TC) * D + c0 + 16 * q + rloc;
#if WKV_MODE == 1
                if ((ch & 1) == 0) *(u32x2*)(WSP(bf16, A_H0G) + (size_t)(bh * 64 + (ch >> 1)) * 4096 + (16 * q + rloc) * 64 + k4) = pk4((f32x4){S0, S1, S2, S3});
#endif
#pragma unroll 4
                for (int t = 0; t < WK_TC; ++t) {
                    const LAS float* p = cur + t * WK_SF;
                    const f32x4 rv = *(const LAS f32x4*)(p + k4), wv = *(const LAS f32x4*)(p + 64 + k4), kv = *(const LAS f32x4*)(p + 128 + k4), av = *(const LAS f32x4*)(p + 192 + k4), bv = *(const LAS f32x4*)(p + 256 + k4);
                    const float v = p[320 + rloc];
                    float sa = (S0 * av[0] + S1 * av[1]) + (S2 * av[2] + S3 * av[3]);
                    sa = red16(sa);
                    S0 = S0 * wv[0] + (sa * bv[0] + v * kv[0]); S1 = S1 * wv[1] + (sa * bv[1] + v * kv[1]); S2 = S2 * wv[2] + (sa * bv[2] + v * kv[2]); S3 = S3 * wv[3] + (sa * bv[3] + v * kv[3]);
                    float y = (S0 * rv[0] + S1 * rv[1]) + (S2 * rv[2] + S3 * rv[3]);
                    y = red16(y);
                    if ((F.lane & 15) == 0) yp[(size_t)t * D] = y;
                }
            }
            __syncthreads();
        }
    }
}
__device__ __forceinline__ void ph_lru1(const Args& a, const Frame& F) {
    const bf16* AT = WSP(bf16, A_AT); const bf16* BT = WSP(bf16, A_BT); float* CAR = WSP(float, A_CAR);
    for (int it = F.bid; it < NB * 64; it += F.G) {
        const int b = it >> 6, ch = it & 63, c = 2 * F.tid; const size_t off = (size_t)(b * T + ch * 64) * D + c;
        float P0 = 1.f, P1 = 1.f, h0 = 0.f, h1 = 0.f;
#pragma unroll 8
        for (int t = 0; t < 64; ++t) { const unsigned aw = *(const unsigned*)(AT + off + (size_t)t * D), bw = *(const unsigned*)(BT + off + (size_t)t * D);
            const float a0 = __expf(bf2f(aw & 0xffffu)), a1 = __expf(__uint_as_float(aw & 0xffff0000u)); h0 = a0 * h0 + bf2f(bw & 0xffffu); h1 = a1 * h1 + __uint_as_float(bw & 0xffff0000u); P0 *= a0; P1 *= a1; }
        *(f32x2*)(CAR + ((size_t)(b * 64 + ch) * 2 + 0) * D + c) = (f32x2){P0, P1}; *(f32x2*)(CAR + ((size_t)(b * 64 + ch) * 2 + 1) * D + c) = (f32x2){h0, h1};
    }
}
__device__ __forceinline__ void ph_lru2(const Args& a, const Frame& F) {
    const bf16* AT = WSP(bf16, A_AT); const bf16* BT = WSP(bf16, A_BT); const float* CAR = WSP(float, A_CAR); const bf16* GATE = WSP(bf16, A_GATE); bf16* HG = WSP(bf16, A_HG);
    for (int it = F.bid; it < NB * 64; it += F.G) {
        const int b = it >> 6, ch = it & 63, c = 2 * F.tid; const size_t off = (size_t)(b * T + ch * 64) * D + c;
        float h0 = 0.f, h1 = 0.f;
#pragma unroll 1
        for (int j0 = 0; j0 < ch; j0 += 8) { f32x2 P[8], Hl[8];
#pragma unroll
            for (int q = 0; q < 8; ++q) { const int j = (j0 + q < ch) ? j0 + q : ch - 1; P[q] = *(const f32x2*)(CAR + ((size_t)(b * 64 + j) * 2 + 0) * D + c); Hl[q] = *(const f32x2*)(CAR + ((size_t)(b * 64 + j) * 2 + 1) * D + c); }
#pragma unroll
            for (int q = 0; q < 8; ++q) if (j0 + q < ch) { h0 = P[q][0] * h0 + Hl[q][0]; h1 = P[q][1] * h1 + Hl[q][1]; } }
#pragma unroll 1
        for (int tb = 0; tb < 64; tb += 16) { unsigned aw[16], bw[16], gw[16];
#pragma unroll
            for (int t = 0; t < 16; ++t) { aw[t] = *(const unsigned*)(AT + off + (size_t)(tb + t) * D); bw[t] = *(const unsigned*)(BT + off + (size_t)(tb + t) * D); gw[t] = *(const unsigned*)(GATE + off + (size_t)(tb + t) * D); }
#pragma unroll
            for (int t = 0; t < 16; ++t) { h0 = __expf(bf2f(aw[t] & 0xffffu)) * h0 + bf2f(bw[t] & 0xffffu); h1 = __expf(__uint_as_float(aw[t] & 0xffff0000u)) * h1 + __uint_as_float(bw[t] & 0xffff0000u);
                *(unsigned*)(HG + off + (size_t)(tb + t) * D) = cvt_pk_bf16(h0 * bf2f(gw[t] & 0xffffu), h1 * __uint_as_float(gw[t] & 0xffff0000u)); } }
    }
}
constexpr int LDK = 72, MATB = 64 * LDK * 2;
constexpr int LA_AT = 0, LA_BT = MATB, LA_KT = 2 * MATB, LA_UT = 0, LA_RT = 3 * MATB, LA_ATT = 4 * MATB, LA_BHT = 5 * MATB, LA_KHT = 6 * MATB, LA_VT = 7 * MATB;
constexpr int ABS = 68;
constexpr int LA_CUM = 8 * MATB, LA_AAK = LA_CUM + 64 * ABS * 4, LA_MRB = LA_AAK + MATB, LA_MRK = LA_MRB + MATB, LA_AKV = LA_MRK + MATB, LA_PL = LA_AKV + 64 * ABS * 4, LA_SEG = LA_PL + 256, LA_END = LA_SEG + 2048;
constexpr int LA_QS = LA_AAK, LA_CTS = LA_CUM, LA_Y0S = LA_AKV, LA_GS = LA_AKV + 8192;
constexpr int LA_DG = LA_CUM, LA_ABN = LA_CUM + 4096, LA_TI = LA_KT, LA_YT = LA_AAK;
constexpr int LA_BHN = LA_AAK, LA_KHN = LA_MRB, LA_VN = LA_MRK;
static_assert(LA_END <= LDS_BYTES - 1024, "wkv stage A LDS map");
__device__ __forceinline__ f32x4 mma16(const bf16x8 a, const bf16x8 b, const f32x4 c) { return __builtin_amdgcn_mfma_f32_16x16x32_bf16(a, b, c, 0, 0, 0); }
__device__ __forceinline__ bf16x8 ldsfrag(const LAS unsigned char* base, int row, int ks, int fq) { return *(const LAS bf16x8*)(base + (row * LDK + ks * 32 + fq * 8) * 2); }
#define LBAR() do { asm volatile("s_waitcnt lgkmcnt(0)" ::: "memory"); __builtin_amdgcn_s_barrier(); asm volatile("" ::: "memory"); } while (0)

__device__ __forceinline__ void ph_wkv_a(const Args& a, const Frame& F) {
    const bf16* RKV = WSP(bf16, A_RKV); const bf16* L2O = WSP(bf16, A_L2O);
    LAS unsigned char* L = F.lds; LAS float* CUM = (LAS float*)(L + LA_CUM); LAS float* PL = (LAS float*)(L + LA_PL); LAS float* SEG = (LAS float*)(L + LA_SEG);
    const int tid = F.tid, lane = F.lane, w = F.wave, fr = lane & 15, fq = lane >> 4;
    const int NIT = NB * NH * 64, IPW = (NIT + F.G - 1) / F.G;
    const int t = tid >> 3, k0 = (tid & 7) * 8;
    int item = F.bid * IPW; const int item_end = (item + IPW < NIT) ? item + IPW : NIT;
    u32x4 raw[5]; float pw0[8], pa0[8], pkk[8], pka[8], prk[8]; int pbh = -1;
    auto issue = [&](int it) { const int bh = it >> 6, c = it & 63, b = bh >> 4, hd = bh & 15; const size_t off = (size_t)(b * T + c * 64 + t) * D + hd * 64 + k0;
        raw[0] = *(const u32x4*)(RKV + off); raw[1] = *(const u32x4*)(RKV + (size_t)M * D + off); raw[2] = *(const u32x4*)(RKV + (size_t)2 * M * D + off); raw[3] = *(const u32x4*)(L2O + off); raw[4] = *(const u32x4*)(L2O + (size_t)M * D + off); };
    if (item < item_end) issue(item);
    for (; item < item_end; ++item) {
        const int bh = item >> 6, hd = bh & 15, ch0 = hd * 64;
        if (bh != pbh) { pbh = bh;
#pragma unroll
            for (int e = 0; e < 8; ++e) { pw0[e] = a.in[I_W0][ch0 + k0 + e]; pa0[e] = a.in[I_A0][ch0 + k0 + e]; pkk[e] = a.in[I_KK][ch0 + k0 + e]; pka[e] = a.in[I_KA][ch0 + k0 + e]; prk[e] = a.in[I_RK][ch0 + k0 + e]; } }
        f32x2p rr[4], vv[4], ain[4], bin[4], kmod[4];
        { float f0[8], f1[8], f2[8], f3[8], f4[8]; unpack8(raw[0], f0); unpack8(raw[1], f1); unpack8(raw[2], f2); unpack8(raw[3], f3); unpack8(raw[4], f4);
          f32x2p kk[4], av[4], kx[4], ss2 = (f32x2p){0.f, 0.f}; float ld[8];
#pragma unroll
          for (int h = 0; h < 4; ++h) { rr[h] = (f32x2p){f0[2 * h], f0[2 * h + 1]}; kx[h] = (f32x2p){f1[2 * h], f1[2 * h + 1]}; vv[h] = (f32x2p){f2[2 * h], f2[2 * h + 1]};
              const f32x2p lw = (f32x2p){f3[2 * h], f3[2 * h + 1]}, la = (f32x2p){f4[2 * h], f4[2 * h + 1]}, w0 = (f32x2p){pw0[2 * h], pw0[2 * h + 1]}, a0 = (f32x2p){pa0[2 * h], pa0[2 * h + 1]}, ck = (f32x2p){pkk[2 * h], pkk[2 * h + 1]};
              const f32x2p e1 = exp2_2((w0 + lw) * -1.4426950408889634f) + 1.0f; f32x2p l2; l2.x = __builtin_amdgcn_logf(e1.x); l2.y = __builtin_amdgcn_logf(e1.y);
              const f32x2p dl = exp2_2(l2 * -1.0f - 0.72134752044448170f) * -1.4426950408889634f; ld[2 * h] = dl.x; ld[2 * h + 1] = dl.y;
              av[h] = sigmoid2(a0 + la); kk[h] = kx[h] * ck; ss2 = kk[h] * kk[h] + ss2; }
          float ss = ss2.x + ss2.y;
          ss += __shfl_xor(ss, 1); ss += __shfl_xor(ss, 2); ss += __shfl_xor(ss, 4);
          const float inv = __builtin_amdgcn_rsqf(fmaxf(ss, 1e-24f)); f32x2p bs2 = (f32x2p){0.f, 0.f};
#pragma unroll
          for (int h = 0; h < 4; ++h) { const f32x2p kn = kk[h] * inv, ka = (f32x2p){pka[2 * h], pka[2 * h + 1]}, rk = (f32x2p){prk[2 * h], prk[2 * h + 1]}; ain[h] = kn * -1.0f; bin[h] = kn * av[h]; kmod[h] = kx[h] * ((av[h] - 1.0f) * ka + 1.0f);
              bs2 = rr[h] * kmod[h] * rk + bs2; }
          { float bsum = bs2.x + bs2.y;
            bsum += __shfl_xor(bsum, 1); bsum += __shfl_xor(bsum, 2); bsum += __shfl_xor(bsum, 4);
            if ((tid & 7) == 0) WSP(float, A_Y)[(size_t)item * 64 + t] = bsum; }
          *(LAS f32x4*)(CUM + t * 64 + k0) = (f32x4){ld[0], ld[1], ld[2], ld[3]}; *(LAS f32x4*)(CUM + t * 64 + k0 + 4) = (f32x4){ld[4], ld[5], ld[6], ld[7]}; }
        if (item + 1 < item_end) issue(item + 1);
        LBAR();
        { const int kq = tid & 63, sg = tid >> 6; float run = 0.f;
#pragma unroll
          for (int e = 0; e < 8; ++e) { run += CUM[(8 * sg + e) * 64 + kq]; CUM[(8 * sg + e) * 64 + kq] = run; }
          SEG[sg * 64 + kq] = run;
          LBAR();
          float offs = 0.f;
#pragma unroll
          for (int q = 0; q < 7; ++q) offs += (q < sg) ? SEG[q * 64 + kq] : 0.f;
#pragma unroll
          for (int e = 0; e < 8; ++e) CUM[(8 * sg + e) * 64 + kq] += offs; }
        LBAR();
        { f32x2p o1[4], o2[4], o3[4], o4[4], o5[4], o6[4];
#pragma unroll
          for (int q = 0; q < 2; ++q) { const f32x4 ct4 = *(const LAS f32x4*)(CUM + t * 64 + k0 + 4 * q), cl4 = *(const LAS f32x4*)(CUM + 63 * 64 + k0 + 4 * q); f32x4 cm4 = (f32x4){0.f, 0.f, 0.f, 0.f}; if (t > 0) cm4 = *(const LAS f32x4*)(CUM + (t - 1) * 64 + k0 + 4 * q);
#pragma unroll
              for (int hh = 0; hh < 2; ++hh) { const int h = 2 * q + hh; const f32x2p ct = hh ? P2HI(ct4) : P2LO(ct4), cm = hh ? P2HI(cm4) : P2LO(cm4), cl = hh ? P2HI(cl4) : P2LO(cl4);
                  const f32x2p p = exp2_2(ct), pm1 = exp2_2(cm), ip = exp2_2(ct * -1.0f), pr = exp2_2(cl - ct);
                  o1[h] = ain[h] * pm1; o2[h] = bin[h] * ip; o3[h] = kmod[h] * ip; o4[h] = rr[h] * p; o5[h] = bin[h] * pr; o6[h] = kmod[h] * pr;
                  if (t == 63) { PL[k0 + 2 * h] = p.x; PL[k0 + 2 * h + 1] = p.y; } } }
          const int no = (t * LDK + k0) * 2; u32x4 q;
          q.x = cvt_pk_bf16(o1[0].x, o1[0].y); q.y = cvt_pk_bf16(o1[1].x, o1[1].y); q.z = cvt_pk_bf16(o1[2].x, o1[2].y); q.w = cvt_pk_bf16(o1[3].x, o1[3].y); *(LAS u32x4*)(L + LA_AT + no) = q;
          q.x = cvt_pk_bf16(o2[0].x, o2[0].y); q.y = cvt_pk_bf16(o2[1].x, o2[1].y); q.z = cvt_pk_bf16(o2[2].x, o2[2].y); q.w = cvt_pk_bf16(o2[3].x, o2[3].y); *(LAS u32x4*)(L + LA_BT + no) = q;
          q.x = cvt_pk_bf16(o3[0].x, o3[0].y); q.y = cvt_pk_bf16(o3[1].x, o3[1].y); q.z = cvt_pk_bf16(o3[2].x, o3[2].y); q.w = cvt_pk_bf16(o3[3].x, o3[3].y); *(LAS u32x4*)(L + LA_KT + no) = q;
          q.x = cvt_pk_bf16(o4[0].x, o4[0].y); q.y = cvt_pk_bf16(o4[1].x, o4[1].y); q.z = cvt_pk_bf16(o4[2].x, o4[2].y); q.w = cvt_pk_bf16(o4[3].x, o4[3].y); *(LAS u32x4*)(L + LA_RT + no) = q;
          q.x = cvt_pk_bf16(o5[0].x, o5[0].y); q.y = cvt_pk_bf16(o5[1].x, o5[1].y); q.z = cvt_pk_bf16(o5[2].x, o5[2].y); q.w = cvt_pk_bf16(o5[3].x, o5[3].y); *(LAS u32x4*)(L + LA_BHN + no) = q;
          q.x = cvt_pk_bf16(o6[0].x, o6[0].y); q.y = cvt_pk_bf16(o6[1].x, o6[1].y); q.z = cvt_pk_bf16(o6[2].x, o6[2].y); q.w = cvt_pk_bf16(o6[3].x, o6[3].y); *(LAS u32x4*)(L + LA_KHN + no) = q;
          q.x = cvt_pk_bf16(vv[0].x, vv[0].y); q.y = cvt_pk_bf16(vv[1].x, vv[1].y); q.z = cvt_pk_bf16(vv[2].x, vv[2].y); q.w = cvt_pk_bf16(vv[3].x, vv[3].y); *(LAS u32x4*)(L + LA_VN + no) = q; }
        LBAR();
        { const int kq = tid & 63, tb = tid >> 6;
#pragma unroll
          for (int mi = 0; mi < 4; ++mi) { const int so = (mi == 0) ? LA_AT : ((mi == 1) ? LA_BHN : ((mi == 2) ? LA_KHN : LA_VN)), dofs = (mi == 0) ? LA_ATT : ((mi == 1) ? LA_BHT : ((mi == 2) ? LA_KHT : LA_VT));
              unsigned h[8];
#pragma unroll
              for (int e = 0; e < 8; ++e) h[e] = *(const LAS bf16*)(L + so + ((8 * tb + e) * LDK + kq) * 2);
              u32x4 q; q.x = h[0] | (h[1] << 16); q.y = h[2] | (h[3] << 16); q.z = h[4] | (h[5] << 16); q.w = h[6] | (h[7] << 16);
              *(LAS u32x4*)(L + dofs + (kq * LDK + 8 * tb) * 2) = q; } }
        LBAR();
        { const int prod = w & 3, th = w >> 2; const LAS unsigned char* aM = L + ((prod & 1) ? LA_KT : LA_BT); const LAS unsigned char* bM = L + ((prod < 2) ? LA_AT : LA_RT);
#pragma unroll
          for (int tt = 0; tt < 2; ++tt) { const int tti = 2 * th + tt, t0 = tti * 16; const bf16x8 b0 = ldsfrag(bM, t0 + fr, 0, fq), b1 = ldsfrag(bM, t0 + fr, 1, fq);
#pragma unroll
              for (int st = 0; st < 4; ++st) { const int s0 = st * 16; f32x4 z = (f32x4){0.f, 0.f, 0.f, 0.f};
                  if (st <= tti) { z = mma16(ldsfrag(aM, s0 + fr, 0, fq), b0, z); z = mma16(ldsfrag(aM, s0 + fr, 1, fq), b1, z); }
                  const int tq = t0 + fr, sb = s0 + 4 * fq;
                  if (st == tti) {
#pragma unroll
                      for (int r = 0; r < 4; ++r) { const bool keep = (prod < 2) ? (sb + r < tq) : (sb + r <= tq); z[r] = keep ? z[r] : 0.f; } }
                  if (prod == 0) {
                      if (st == tti) { *(LAS f32x4*)(L + LA_DG + ((tti * 16 + fr) * 16 + 4 * fq) * 4) = z; z = (f32x4){0.f, 0.f, 0.f, 0.f}; }
                      *(LAS u32x2*)(L + LA_ABN + (tq * LDK + sb) * 2) = pk4(z); }
                  else { const int mo = (prod == 1) ? LA_AAK : ((prod == 2) ? LA_MRB : LA_MRK); *(LAS u32x2*)(L + mo + (tq * LDK + sb) * 2) = pk4(z); } } } }
        LBAR();
        if (w == 0) {
          const int tb = lane >> 4, tc = lane & 15; float Tc[16];
#pragma unroll
          for (int r = 0; r < 16; ++r) { float av[16];
#pragma unroll
              for (int q = 0; q < (r + 3) / 4; ++q) { const f32x4 t4 = *(const LAS f32x4*)(L + LA_DG + ((tb * 16 + r) * 16 + 4 * q) * 4); av[4 * q] = t4[0]; av[4 * q + 1] = t4[1]; av[4 * q + 2] = t4[2]; av[4 * q + 3] = t4[3]; }
              float s0 = (r == tc) ? 1.f : 0.f, s1 = 0.f;
#pragma unroll
              for (int j = 0; j < r; ++j) { if (j & 1) s1 += av[j] * Tc[j]; else s0 += av[j] * Tc[j]; }
              Tc[r] = s0 + s1; }
#pragma unroll
          for (int r = 0; r < 16; ++r) *(LAS bf16*)(L + LA_TI + ((tb * 16 + r) * 32 + tc) * 2) = (bf16)(cvt_pk_bf16(Tc[r], 0.f) & 0xffffu);
        } else {
#pragma unroll 1
          for (int q = w - 1; q < 16; q += 7) { const int v0 = (q >> 2) * 16, t0 = (q & 3) * 16; f32x4 z = (f32x4){0.f, 0.f, 0.f, 0.f};
              z = mma16(ldsfrag(L + LA_AAK, t0 + fr, 0, fq), ldsfrag(L + LA_VT, v0 + fr, 0, fq), z); z = mma16(ldsfrag(L + LA_AAK, t0 + fr, 1, fq), ldsfrag(L + LA_VT, v0 + fr, 1, fq), z);
              *(LAS f32x4*)(L + LA_AKV + ((v0 + fr) * ABS + t0 + 4 * fq) * 4) = z; }
        }
        LBAR();
        { const int col = 16 * w + fr; u32x2 ub[4];
#pragma unroll
          for (int i = 0; i < 4; ++i) ub[i] = (u32x2){0u, 0u};
#pragma unroll
          for (int i = 0; i < 4; ++i) {
              f32x4 y;
              if (w < 4) y = unpk4(*(const LAS u32x2*)(L + LA_ATT + (col * LDK + 16 * i + 4 * fq) * 2)); else y = *(const LAS f32x4*)(L + LA_AKV + ((col - 64) * ABS + 16 * i + 4 * fq) * 4);
#pragma unroll
              for (int ks = 0; ks < (i + 1) / 2; ++ks) { const int j0 = 2 * ks;
                  const u32x2 alo = *(const LAS u32x2*)(L + LA_ABN + ((16 * i + fr) * LDK + 16 * j0 + 4 * fq) * 2), ahi = *(const LAS u32x2*)(L + LA_ABN + ((16 * i + fr) * LDK + 16 * (j0 + 1) + 4 * fq) * 2);
                  y = mma16(__builtin_bit_cast(bf16x8, (u32x4){alo.x, alo.y, ahi.x, ahi.y}), __builtin_bit_cast(bf16x8, (u32x4){ub[j0].x, ub[j0].y, ub[j0 + 1].x, ub[j0 + 1].y}), y); }
              const u32x2 yp = pk4(y), tlo = *(const LAS u32x2*)(L + LA_TI + ((i * 16 + fr) * 32 + 4 * fq) * 2);
              const f32x4 uo = mma16(__builtin_bit_cast(bf16x8, (u32x4){tlo.x, tlo.y, 0u, 0u}), __builtin_bit_cast(bf16x8, (u32x4){yp.x, yp.y, 0u, 0u}), (f32x4){0.f, 0.f, 0.f, 0.f});
              ub[i] = pk4(uo);
              *(LAS u32x2*)(L + LA_UT + (col * LDK + 16 * i + 4 * fq) * 2) = ub[i];
          } }
        LBAR();
        { const int kind = w >> 1, half = w & 1; const size_t ib = (size_t)item * 4096;
#pragma unroll
          for (int jj = 0; jj < 2; ++jj) { const int j0 = (2 * half + jj) * 16;
#pragma unroll
              for (int it = 0; it < 4; ++it) { const int i0 = it * 16; f32x4 z = (f32x4){0.f, 0.f, 0.f, 0.f};
                  if (kind == 0) {
                      z = mma16(ldsfrag(L + LA_UT, i0 + fr, 0, fq), ldsfrag(L + LA_MRB, j0 + fr, 0, fq), z); z = mma16(ldsfrag(L + LA_UT, i0 + fr, 1, fq), ldsfrag(L + LA_MRB, j0 + fr, 1, fq), z);
                      z += unpk4(*(const LAS u32x2*)(L + LA_RT + ((j0 + fr) * LDK + i0 + 4 * fq) * 2));
                      *(u32x2*)(WSP(bf16, A_QG) + ib + (j0 + fr) * 64 + i0 + 4 * fq) = pk4(z);
                  } else if (kind == 1) {
                      z = mma16(ldsfrag(L + LA_UT, 64 + i0 + fr, 0, fq), ldsfrag(L + LA_MRB, j0 + fr, 0, fq), z); z = mma16(ldsfrag(L + LA_UT, 64 + i0 + fr, 1, fq), ldsfrag(L + LA_MRB, j0 + fr, 1, fq), z);
                      z = mma16(ldsfrag(L + LA_VT, i0 + fr, 0, fq), ldsfrag(L + LA_MRK, j0 + fr, 0, fq), z); z = mma16(ldsfrag(L + LA_VT, i0 + fr, 1, fq), ldsfrag(L + LA_MRK, j0 + fr, 1, fq), z);
                      *(u32x2*)(WSP(bf16, A_Y0G) + ib + (j0 + fr) * 64 + i0 + 4 * fq) = pk4(z);
                  } else if (kind == 2) {
                      z = mma16(ldsfrag(L + LA_UT, i0 + fr, 0, fq), ldsfrag(L + LA_BHT, j0 + fr, 0, fq), z); z = mma16(ldsfrag(L + LA_UT, i0 + fr, 1, fq), ldsfrag(L + LA_BHT, j0 + fr, 1, fq), z);
                      const float pl = PL[j0 + fr];
#pragma unroll
                      for (int r = 0; r < 4; ++r) z[r] += (i0 + 4 * fq + r == j0 + fr) ? pl : 0.f;
                      *(u32x2*)(WSP(bf16, A_GG) + ib + (j0 + fr) * 64 + i0 + 4 * fq) = pk4(z);
                  } else {
                      z = mma16(ldsfrag(L + LA_BHT, i0 + fr, 0, fq), ldsfrag(L + LA_UT, 64 + j0 + fr, 0, fq), z); z = mma16(ldsfrag(L + LA_BHT, i0 + fr, 1, fq), ldsfrag(L + LA_UT, 64 + j0 + fr, 1, fq), z);
                      z = mma16(ldsfrag(L + LA_KHT, i0 + fr, 0, fq), ldsfrag(L + LA_VT, j0 + fr, 0, fq), z); z = mma16(ldsfrag(L + LA_KHT, i0 + fr, 1, fq), ldsfrag(L + LA_VT, j0 + fr, 1, fq), z);
                      *(f32x4*)(WSP(float, A_CTG) + ib + (j0 + fr) * 64 + i0 + 4 * fq) = z;
                  } } } }
    }
    __syncthreads();
}
__device__ __forceinline__ void wkv_b_load(const bf16* GG, const float* CTG, int item, int v0, int kb, int fr, int fq, bf16x8 (&ga)[2][2], f32x4 (&ct)[2]) {
    const size_t ib = (size_t)item * 4096;
#pragma unroll
    for (int kk = 0; kk < 2; ++kk) { const int k0 = (kb + kk) * 16; ct[kk] = *(const f32x4*)(CTG + ib + (v0 + fr) * 64 + k0 + 4 * fq);
#pragma unroll
        for (int ks = 0; ks < 2; ++ks) ga[kk][ks] = *(const bf16x8*)(GG + ib + (k0 + fr) * 64 + ks * 32 + fq * 8); }
}
__device__ __forceinline__ void wkv_b_step(LAS unsigned char* L, bf16* H0G, int item, int c, int tid, int v0, int kb, int fr, int fq, const bf16x8 (&ga)[2][2], const f32x4 (&ct)[2]) {
    const LAS unsigned char* cur = L + (c & 1) * MATB; LAS unsigned char* nxt = L + ((c + 1) & 1) * MATB;
    { const int row = tid >> 3, seg = tid & 7; *(u32x4*)(H0G + (size_t)item * 4096 + row * 64 + seg * 8) = *(const LAS u32x4*)(cur + (row * LDK + seg * 8) * 2); }
#pragma unroll
    for (int kk = 0; kk < 2; ++kk) { f32x4 z = ct[kk]; z = mma16(ga[kk][0], ldsfrag(cur, v0 + fr, 0, fq), z); z = mma16(ga[kk][1], ldsfrag(cur, v0 + fr, 1, fq), z);
        *(LAS u32x2*)(nxt + ((v0 + fr) * LDK + (kb + kk) * 16 + 4 * fq) * 2) = pk4(z); }
    LBAR();
}
__device__ __forceinline__ void ph_wkv_b(const Args& a, const Frame& F) {
    LAS unsigned char* L = F.lds; const int tid = F.tid, lane = F.lane, w = F.wave, fr = lane & 15, fq = lane >> 4;
    const bf16* GG = WSP(bf16, A_GG); const float* CTG = WSP(float, A_CTG); bf16* H0G = WSP(bf16, A_H0G);
    for (int bh = F.bid; bh < NB * NH; bh += F.G) {
        for (int i = tid; i < 2 * MATB / 4; i += NTHR) ((LAS unsigned*)L)[i] = 0u;
        const int v0 = (w >> 1) * 16, kb = 2 * (w & 1);
        bf16x8 gaA[2][2], gaB[2][2], gaC[2][2], gaD[2][2]; f32x4 ctA[2], ctB[2], ctC[2], ctD[2];
        wkv_b_load(GG, CTG, bh * 64, v0, kb, fr, fq, gaA, ctA); wkv_b_load(GG, CTG, bh * 64 + 1, v0, kb, fr, fq, gaB, ctB);
        wkv_b_load(GG, CTG, bh * 64 + 2, v0, kb, fr, fq, gaC, ctC); wkv_b_load(GG, CTG, bh * 64 + 3, v0, kb, fr, fq, gaD, ctD);
        LBAR();
        for (int c = 0; c < 64; c += 4) {
            wkv_b_step(L, H0G, bh * 64 + c, c, tid, v0, kb, fr, fq, gaA, ctA);
            wkv_b_load(GG, CTG, bh * 64 + (c + 4 < 64 ? c + 4 : 63), v0, kb, fr, fq, gaA, ctA);
            wkv_b_step(L, H0G, bh * 64 + c + 1, c + 1, tid, v0, kb, fr, fq, gaB, ctB);
            wkv_b_load(GG, CTG, bh * 64 + (c + 5 < 64 ? c + 5 : 63), v0, kb, fr, fq, gaB, ctB);
            wkv_b_step(L, H0G, bh * 64 + c + 2, c + 2, tid, v0, kb, fr, fq, gaC, ctC);
            wkv_b_load(GG, CTG, bh * 64 + (c + 6 < 64 ? c + 6 : 63), v0, kb, fr, fq, gaC, ctC);
            wkv_b_step(L, H0G, bh * 64 + c + 3, c + 3, tid, v0, kb, fr, fq, gaD, ctD);
            wkv_b_load(GG, CTG, bh * 64 + (c + 7 < 64 ? c + 7 : 63), v0, kb, fr, fq, gaD, ctD);
        }
    }
    __syncthreads();
    { const int nchain = NB * NH, idle0 = (F.G > nchain) ? nchain : 0;
      if (F.bid >= idle0) { LAS float* scr = (LAS float*)(F.lds + F.wave * CONV_SCR); const int gw = (F.bid - idle0) * NWAVES + F.wave, NGW = (F.G - idle0) * NWAVES;
          for (int it = gw; it < B_CONV_ITEMS; it += NGW) conv_dispatch(a, it, scr, F.lane); } }
}
__device__ __forceinline__ void ph_wkv_c(const Args& a, const Frame& F) {
    const bf16* RKV = WSP(bf16, A_RKV); const bf16* L2O = WSP(bf16, A_L2O); bf16* YG = WSP(bf16, A_YG);
    const bf16* QG = WSP(bf16, A_QG); const bf16* Y0G = WSP(bf16, A_Y0G); const bf16* H0G = WSP(bf16, A_H0G);
    const int lane = F.lane, fr = lane & 15, fq = lane >> 4; const int gw = F.bid * NWAVES + F.wave, NGW = F.G * NWAVES;
    for (int item = gw; item < NB * NH * 64; item += NGW) {
        const int bh = item >> 6, c = item & 63, b = bh >> 4, hd = bh & 15, ch0 = hd * 64; const size_t ib = (size_t)item * 4096;
        bf16x8 hf[4][2];
#pragma unroll
        for (int vb = 0; vb < 4; ++vb) { const int vr = 32 * (vb >> 1) + 8 * (fr >> 2) + 4 * (vb & 1) + (fr & 3);
            hf[vb][0] = *(const bf16x8*)(H0G + ib + vr * 64 + fq * 8); hf[vb][1] = *(const bf16x8*)(H0G + ib + vr * 64 + 32 + fq * 8); }
        f32x4 gw4[2][2], gb4[2][2];
#pragma unroll
        for (int g = 0; g < 2; ++g)
#pragma unroll
            for (int n = 0; n < 2; ++n) { gw4[g][n] = *(const f32x4*)(a.in[I_GNW] + ch0 + 32 * g + 8 * fq + 4 * n); gb4[g][n] = *(const f32x4*)(a.in[I_GNB] + ch0 + 32 * g + 8 * fq + 4 * n); }
#pragma unroll 1
        for (int tt = 0; tt < 4; ++tt) {
            const int t0 = tt * 16, row = b * T + c * 64 + t0 + fr;
            const bf16x8 q0 = *(const bf16x8*)(QG + ib + (t0 + fr) * 64 + fq * 8), q1 = *(const bf16x8*)(QG + ib + (t0 + fr) * 64 + 32 + fq * 8);
            f32x4 y[2][2];
#pragma unroll
            for (int g = 0; g < 2; ++g) { float y8[8]; unpack8(*(const u32x4*)(Y0G + ib + (t0 + fr) * 64 + 32 * g + 8 * fq), y8);
#pragma unroll
                for (int n = 0; n < 2; ++n) { y[g][n] = (f32x4){y8[4 * n], y8[4 * n + 1], y8[4 * n + 2], y8[4 * n + 3]}; y[g][n] = mma16(hf[2 * g + n][0], q0, y[g][n]); y[g][n] = mma16(hf[2 * g + n][1], q1, y[g][n]); } }
            float s = 0.f;
#pragma unroll
            for (int g = 0; g < 2; ++g)
#pragma unroll
                for (int n = 0; n < 2; ++n) s += (y[g][n][0] + y[g][n][1]) + (y[g][n][2] + y[g][n][3]);
            s += __shfl_xor(s, 16); s += __shfl_xor(s, 32); const float mean = s * (1.0f / 64.0f);
            float q2 = 0.f;
#pragma unroll
            for (int g = 0; g < 2; ++g)
#pragma unroll
                for (int n = 0; n < 2; ++n)
#pragma unroll
                    for (int r = 0; r < 4; ++r) { const float d = y[g][n][r] - mean; q2 += d * d; }
            q2 += __shfl_xor(q2, 16); q2 += __shfl_xor(q2, 32); const float rstd = __builtin_amdgcn_rsqf(q2 * (1.0f / 64.0f) + 64e-5f);
            const float bs = WSP(float, A_Y)[(size_t)item * 64 + t0 + fr];
#pragma unroll
            for (int g = 0; g < 2; ++g) { const size_t oo = (size_t)row * D + ch0 + 32 * g + 8 * fq; float v8[8], g8[8];
                unpack8(*(const u32x4*)(RKV + (size_t)2 * M * D + oo), v8); unpack8(*(const u32x4*)(L2O + (size_t)2 * M * D + oo), g8);
                f32x4 o[2];
#pragma unroll
                for (int n = 0; n < 2; ++n)
#pragma unroll
                    for (int r = 0; r < 4; ++r) o[n][r] = (((y[g][n][r] - mean) * rstd) * gw4[g][n][r] + gb4[g][n][r] + v8[4 * n + r] * bs) * g8[4 * n + r];
                st_bf16x8(YG + oo, o[0], o[1]); }
        }
    }
}
__global__ void __launch_bounds__(64) k_wkv_naive(Args a) {
    __shared__ float sR[64], sW[64], sK[64], sA[64], sB[64];
    const int bh = blockIdx.x, b = bh >> 4, hd = bh & 15, j = threadIdx.x, c = hd * 64 + j;
    const bf16* RKV = WSP(bf16, A_RKV); const bf16* L2O = WSP(bf16, A_L2O); float* Y = WSP(float, A_Y);
    const float w0 = a.in[I_W0][c], a0 = a.in[I_A0][c], kkw = a.in[I_KK][c], kaw = a.in[I_KA][c];
    float S[64];
#pragma unroll
    for (int k = 0; k < 64; ++k) S[k] = 0.f;
    for (int t = 0; t < T; ++t) {
        const size_t off = (size_t)(b * T + t) * D + c;
        const float r = bf2f(RKV[off]), kx = bf2f(RKV[(size_t)M * D + off]), v = bf2f(RKV[(size_t)2 * M * D + off]);
        const float lw = bf2f(L2O[off]), la = bf2f(L2O[(size_t)M * D + off]);
        const float wlog = -softplusf_(-(w0 + lw)) - 0.5f; const float dec = __expf(-__expf(wlog));
        const float av = sigmoidf_(a0 + la);
        float kk = kx * kkw; const float ss = wave_sum(kk * kk); kk = kk / fmaxf(sqrtf(ss), 1e-12f);
        const float kmod = kx * (1.0f + (av - 1.0f) * kaw);
        __syncthreads();
        sR[j] = r; sW[j] = dec; sK[j] = kmod; sA[j] = -kk; sB[j] = kk * av;
        __syncthreads();
        float sa = 0.f;
#pragma unroll
        for (int k = 0; k < 64; ++k) sa += S[k] * sA[k];
        float y = 0.f;
#pragma unroll
        for (int k = 0; k < 64; ++k) { S[k] = S[k] * sW[k] + sa * sB[k] + v * sK[k]; y += S[k] * sR[k]; }
        Y[off] = y;
    }
}
__device__ __forceinline__ void ph_post(const Args& a, const Frame& F) {
    const bf16* RKV = WSP(bf16, A_RKV); const bf16* L2O = WSP(bf16, A_L2O); const float* Y = WSP(float, A_Y); bf16* YG = WSP(bf16, A_YG);
    const int gw = F.bid * NWAVES + F.wave, NGW = F.G * NWAVES, c0 = 16 * F.lane;
    for (int row = gw; row < M; row += NGW) {
        const size_t off = (size_t)row * D + c0;
        float y[16], r[16], k[16], v[16], la[16], gq[16];
#pragma unroll
        for (int q = 0; q < 4; ++q) { const f32x4 t = *(const f32x4*)(Y + off + 4 * q); y[4 * q] = t[0]; y[4 * q + 1] = t[1]; y[4 * q + 2] = t[2]; y[4 * q + 3] = t[3]; }
#pragma unroll
        for (int q = 0; q < 2; ++q) { float f[8];
            unpack8(*(const u32x4*)(RKV + off + 8 * q), f);
#pragma unroll
            for (int e = 0; e < 8; ++e) r[8 * q + e] = f[e];
            unpack8(*(const u32x4*)(RKV + (size_t)M * D + off + 8 * q), f);
#pragma unroll
            for (int e = 0; e < 8; ++e) k[8 * q + e] = f[e];
            unpack8(*(const u32x4*)(RKV + (size_t)2 * M * D + off + 8 * q), f);
#pragma unroll
            for (int e = 0; e < 8; ++e) v[8 * q + e] = f[e];
            unpack8(*(const u32x4*)(L2O + (size_t)M * D + off + 8 * q), f);
#pragma unroll
            for (int e = 0; e < 8; ++e) la[8 * q + e] = f[e];
            unpack8(*(const u32x4*)(L2O + (size_t)2 * M * D + off + 8 * q), f);
#pragma unroll
            for (int e = 0; e < 8; ++e) gq[8 * q + e] = f[e]; }
        float s = 0.f;
#pragma unroll
        for (int e = 0; e < 16; ++e) s += y[e];
        s += __shfl_xor(s, 1); s += __shfl_xor(s, 2); const float mean = s * (1.0f / 64.0f);
        float q2 = 0.f;
#pragma unroll
        for (int e = 0; e < 16; ++e) { const float d = y[e] - mean; q2 += d * d; }
        q2 += __shfl_xor(q2, 1); q2 += __shfl_xor(q2, 2); const float rstd = 1.0f / sqrtf(q2 * (1.0f / 64.0f) + 64e-5f);
        float bs = 0.f;
#pragma unroll
        for (int e = 0; e < 16; ++e) { const float av = sigmoidf_(a.in[I_A0][c0 + e] + la[e]); const float km = k[e] * (1.0f + (av - 1.0f) * a.in[I_KA][c0 + e]); bs += r[e] * km * a.in[I_RK][c0 + e]; }
        bs += __shfl_xor(bs, 1); bs += __shfl_xor(bs, 2);
        float o[16];
#pragma unroll
        for (int e = 0; e < 16; ++e) o[e] = ((y[e] - mean) * rstd * a.in[I_GNW][c0 + e] + a.in[I_GNB][c0 + e] + bs * v[e]) * gq[e];
        u32x4 w0, w1; w0.x = cvt_pk_bf16(o[0], o[1]); w0.y = cvt_pk_bf16(o[2], o[3]); w0.z = cvt_pk_bf16(o[4], o[5]); w0.w = cvt_pk_bf16(o[6], o[7]);
        w1.x = cvt_pk_bf16(o[8], o[9]); w1.y = cvt_pk_bf16(o[10], o[11]); w1.z = cvt_pk_bf16(o[12], o[13]); w1.w = cvt_pk_bf16(o[14], o[15]);
        *(u32x4*)(YG + off) = w0; *(u32x4*)(YG + off + 8) = w1;
    }
}
__device__ __forceinline__ void ph_conv(const Args& a, const Frame& F) {
    const bf16* XB = WSP(bf16, A_XB); bf16* XBC = WSP(bf16, A_XBC);
    const int gt = F.bid * NTHR + F.tid, NGT = F.G * NTHR;
    for (int it = gt; it < M * 128; it += NGT) {
        const int row = it >> 7, c0 = (it & 127) * 8, t = row & (T - 1);
        float acc[8];
#pragma unroll
        for (int e = 0; e < 8; ++e) acc[e] = a.in[I_CONVB][c0 + e];
#pragma unroll
        for (int j = 0; j < 4; ++j) { const int tt = t - 3 + j; if (tt >= 0) { float f[8]; unpack8(*(const u32x4*)(XB + (size_t)(row - 3 + j) * D + c0), f);
#pragma unroll
                for (int e = 0; e < 8; ++e) acc[e] += a.in[I_CONVW][j * D + c0 + e] * f[e]; } }
        u32x4 w; w.x = cvt_pk_bf16(acc[0], acc[1]); w.y = cvt_pk_bf16(acc[2], acc[3]); w.z = cvt_pk_bf16(acc[4], acc[5]); w.w = cvt_pk_bf16(acc[6], acc[7]);
        *(u32x4*)(XBC + (size_t)row * D + c0) = w;
    }
}
__global__ void __launch_bounds__(256) k_lru_naive(Args a) {
    const int id = blockIdx.x * 256 + threadIdx.x, b = id >> 10, c = id & 1023;
    const float* AT = WSP(float, A_AT); const float* BT = WSP(float, A_BT); const bf16* GATE = WSP(bf16, A_GATE); bf16* HG = WSP(bf16, A_HG);
    float h = 0.f;
    for (int t = 0; t < T; ++t) { const size_t off = (size_t)(b * T + t) * D + c; h = AT[off] * h + BT[off]; HG[off] = (bf16)(cvt_pk_bf16(h * bf2f(GATE[off]), 0.f) & 0xffffu); }
}
__device__ __forceinline__ void ph_route1(const Args& a, const Frame& F) {
    const xres_t* X = XRES(a); const float* mod = WSP(float, WS_MOD); bf16* H = WSP(bf16, A_H);
    LAS int* cnt = (LAS int*)F.lds;
    f32x4 wa[16], wb[16];
#pragma unroll
    for (int j = 0; j < 4; ++j)
#pragma unroll
        for (int i = 0; i < 4; ++i) { const int d = 4 * F.lane + 256 * j + i; wa[4 * j + i] = *(const f32x4*)(a.in[I_ROUTW] + d * 8); wb[4 * j + i] = *(const f32x4*)(a.in[I_ROUTW] + d * 8 + 4); }
    float rb[8];
#pragma unroll
    for (int e = 0; e < 8; ++e) rb[e] = a.in[I_ROUTB][e];
    for (int wg = F.bid; wg < M / 64; wg += F.G) {
        if (F.tid < 8) cnt[F.tid] = 0;
        __syncthreads();
        const int r0 = wg * 64 + F.wave * 8, b = r0 >> 12; const float* mb = mod + (size_t)(1 * 4 + b) * MODW + 3072;
        f32x4 gm[4], shv[4], h[4];
        load_gm_sh(a.in[I_NORMG] + (1 * 2 + 1) * D, mb + 0, mb + 1024, F.lane, gm, shv);
        for (int r = 0; r < 8; ++r) {
            const int row = r0 + r; mod_row(X + (size_t)row * D, gm, shv, F.lane, h);
#if MOE_FP8
            { unsigned char* h8 = (unsigned char*)H + (size_t)row * D;
#pragma unroll
              for (int j = 0; j < 4; ++j) *(unsigned*)(h8 + 4 * F.lane + 256 * j) = pk_fp8x4(h[j][0], h[j][1], h[j][2], h[j][3]); }
#else
            store_row_bf16(H + (size_t)row * D, h, F.lane);
#endif
            float lg[8];
#pragma unroll
            for (int e = 0; e < 8; ++e) lg[e] = 0.f;
#pragma unroll
            for (int j = 0; j < 4; ++j)
#pragma unroll
                for (int i = 0; i < 4; ++i) { const f32x4 w0 = wa[4 * j + i], w1 = wb[4 * j + i]; const float hv = h[j][i];
                    lg[0] += hv * w0[0]; lg[1] += hv * w0[1]; lg[2] += hv * w0[2]; lg[3] += hv * w0[3]; lg[4] += hv * w1[0]; lg[5] += hv * w1[1]; lg[6] += hv * w1[2]; lg[7] += hv * w1[3]; }
            { const bool up = (F.lane & 32) != 0; float t[4];
#pragma unroll
              for (int i = 0; i < 4; ++i) { const float keep = up ? lg[i + 4] : lg[i], send = up ? lg[i] : lg[i + 4]; t[i] = keep + __shfl_xor(send, 32); }
              const bool up2 = (F.lane & 16) != 0; float u2[2];
#pragma unroll
              for (int i = 0; i < 2; ++i) { const float keep = up2 ? t[i + 2] : t[i], send = up2 ? t[i] : t[i + 2]; u2[i] = keep + __shfl_xor(send, 16); }
              const bool up3 = (F.lane & 8) != 0; float v1 = (up3 ? u2[1] : u2[0]) + __shfl_xor(up3 ? u2[0] : u2[1], 8);
              v1 += __shfl_xor(v1, 4); v1 += __shfl_xor(v1, 2); v1 += __shfl_xor(v1, 1);
#pragma unroll
              for (int e = 0; e < 8; ++e) lg[e] = __builtin_bit_cast(float, __builtin_amdgcn_readlane(__builtin_bit_cast(int, v1), 8 * e)) + rb[e]; }
            int i0 = 0; float v0 = lg[0];
#pragma unroll
            for (int e = 1; e < 8; ++e) if (lg[e] > v0) { v0 = lg[e]; i0 = e; }
            int i1 = -1; float v1 = -3.0e38f;
#pragma unroll
            for (int e = 0; e < 8; ++e) if (e != i0 && lg[e] > v1) { v1 = lg[e]; i1 = e; }
            const float p0 = 1.0f / (1.0f + __expf(v1 - v0)), p1 = 1.0f - p0;
            if (F.lane == 0) { WSP(i32x2, WS_SEL)[row] = (i32x2){i0, i1}; WSP(f32x2, WS_PROB)[row] = (f32x2){p0, p1}; __hip_atomic_fetch_add(&cnt[i0], 1, __ATOMIC_RELAXED, __HIP_MEMORY_SCOPE_WORKGROUP); __hip_atomic_fetch_add(&cnt[i1], 1, __ATOMIC_RELAXED, __HIP_MEMORY_SCOPE_WORKGROUP); }
        }
        __syncthreads();
        if (F.tid < 8) WSP(int, WS_CNT)[wg * 8 + F.tid] = cnt[F.tid];
        __syncthreads();
    }
}
__device__ __forceinline__ void ph_route2(const Args& a, const Frame& F) {
    const bf16* H = WSP(bf16, A_H); bf16* HSb = WSP(bf16, A_HS); const int* CNT = WSP(int, WS_CNT);
    LAS int* lpos = (LAS int*)F.lds;
    LAS int* lps = lpos + 128;
    for (int wg = F.bid; wg < M / 64; wg += F.G) {
        if (F.wave == 0) {
            int below[8], tot[8];
#pragma unroll
            for (int e = 0; e < 8; ++e) { below[e] = 0; tot[e] = 0; }
#pragma unroll
            for (int q = 0; q < 4; ++q) { const int w = F.lane + 64 * q;
#pragma unroll
                for (int e = 0; e < 8; ++e) { const int cv = CNT[w * 8 + e]; tot[e] += cv; below[e] += (w < wg) ? cv : 0; } }
#pragma unroll
            for (int e = 0; e < 8; ++e)
#pragma unroll
                for (int o = 1; o < 64; o <<= 1) { tot[e] += __shfl_xor(tot[e], o); below[e] += __shfl_xor(below[e], o); }
            int ps[9]; ps[0] = 0;
#pragma unroll
            for (int e = 0; e < 8; ++e) ps[e + 1] = ps[e] + ((tot[e] + 255) & ~255);
            const int row = wg * 64 + F.lane; const i32x2 se = WSP(i32x2, WS_SEL)[row]; int p0 = 0, p1 = 0;
#pragma unroll
            for (int e = 0; e < 8; ++e) { const bool mine = (se.x == e) || (se.y == e); const unsigned long long mk = __ballot(mine); const int rank = __popcll(mk & ((1ull << F.lane) - 1ull));
                if (se.x == e) p0 = ps[e] + below[e] + rank; if (se.y == e) p1 = ps[e] + below[e] + rank; }
            WSP(i32x2, WS_POS)[row] = (i32x2){p0, p1}; lpos[2 * F.lane] = p0; lpos[2 * F.lane + 1] = p1;
            if (F.lane == 0) {
#pragma unroll
                for (int e = 0; e < 9; ++e) lps[e] = ps[e];
#pragma unroll
                for (int e = 0; e < 8; ++e) lps[16 + e] = tot[e];
                if (wg == 0) {
#pragma unroll
                    for (int e = 0; e < 9; ++e) WSP(int, WS_PST)[e] = ps[e]; }
            }
        }
        __syncthreads();
        for (int r = 0; r < 8; ++r) { const int tl = F.wave * 8 + r, row = wg * 64 + tl; const int p0 = lpos[2 * tl], p1 = lpos[2 * tl + 1];
#if MOE_FP8
            unsigned char* HS8 = (unsigned char*)HSb; const u32x4 v8 = *(const u32x4*)((const unsigned char*)H + (size_t)row * D + 16 * F.lane);
            *(u32x4*)(HS8 + (size_t)p0 * D + 16 * F.lane) = v8; *(u32x4*)(HS8 + (size_t)p1 * D + 16 * F.lane) = v8; }
        if (wg < 8) { const int e = wg, rs = lps[e] + lps[16 + e], re = lps[e + 1]; const u32x4 z = (u32x4){0u, 0u, 0u, 0u};
            for (int i = rs * 64 + F.tid; i < re * 64; i += NTHR) *(u32x4*)((unsigned char*)HSb + (size_t)i * 16) = z; }
#else
            const u32x4 v0 = *(const u32x4*)(H + (size_t)row * D + 8 * F.lane), v1 = *(const u32x4*)(H + (size_t)row * D + 512 + 8 * F.lane);
            *(u32x4*)(HSb + (size_t)p0 * D + 8 * F.lane) = v0; *(u32x4*)(HSb + (size_t)p0 * D + 512 + 8 * F.lane) = v1;
            *(u32x4*)(HSb + (size_t)p1 * D + 8 * F.lane) = v0; *(u32x4*)(HSb + (size_t)p1 * D + 512 + 8 * F.lane) = v1; }
        if (wg < 8) { const int e = wg, rs = lps[e] + lps[16 + e], re = lps[e + 1]; const u32x4 z = (u32x4){0u, 0u, 0u, 0u};
            for (int i = rs * 128 + F.tid; i < re * 128; i += NTHR) *(u32x4*)(HSb + (size_t)i * 8) = z; }
#endif
        __syncthreads();
    }
}
__device__ __forceinline__ void ph_final(const Args& a, const Frame& F, float* dst) {
    const xres_t* X = XRES(a); const float* mod = WSP(float, WS_MOD); const bf16* YD = WSP(bf16, A_YD);
    const int gw = F.bid * NWAVES + F.wave, NGW = F.G * NWAVES;
    f32x4 fg[4];
#pragma unroll
    for (int j = 0; j < 4; ++j) fg[j] = ((const f32x4*)a.in[I_FINALG])[F.lane + 64 * j];
    for (int rb = gw; rb < M / 8; rb += NGW) {
        const int r0 = rb * 8, b = r0 >> 12; const float* gt = mod + (size_t)(1 * 4 + b) * MODW + 5120;
        f32x4 g[4];
#pragma unroll
        for (int j = 0; j < 4; ++j) g[j] = ((const f32x4*)gt)[F.lane + 64 * j] + 1.0f;
#pragma unroll 2
        for (int r = 0; r < 8; ++r) { const int row = r0 + r;
            const i32x2 pos = WSP(i32x2, WS_POS)[row]; const f32x2 pr = WSP(f32x2, WS_PROB)[row];
            f32x4 v[4]; float ss = 0.f;
#pragma unroll
            for (int j = 0; j < 4; ++j) { const f32x4 xv = xload4(X + (size_t)row * D, F.lane + 64 * j), y0 = unpk4(((const u32x2*)(YD + (size_t)pos.x * D))[F.lane + 64 * j]), y1 = unpk4(((const u32x2*)(YD + (size_t)pos.y * D))[F.lane + 64 * j]);
                v[j] = xv + g[j] * (y0 * pr.x + y1 * pr.y); ss += (v[j][0] * v[j][0] + v[j][1] * v[j][1]) + (v[j][2] * v[j][2] + v[j][3] * v[j][3]); }
            ss = wave_sum(ss); const float rr = 1.0f / sqrtf(ss * (1.0f / D) + 1e-6f);
#pragma unroll
            for (int j = 0; j < 4; ++j) __builtin_nontemporal_store((v[j] * rr) * fg[j], (f32x4*)(dst + (size_t)row * D) + F.lane + 64 * j); }
    }
}
__device__ __forceinline__ void ph_final_plain(const Args& a, const Frame& F, const float* src) {
    float* X = a.out; const int gw = F.bid * NWAVES + F.wave, NGW = F.G * NWAVES;
    for (int row = gw; row < M; row += NGW) {
        f32x4 v[4]; float ss = 0.f;
#pragma unroll
        for (int j = 0; j < 4; ++j) { v[j] = ((const f32x4*)(src + (size_t)row * D))[F.lane + 64 * j]; ss += (v[j][0] * v[j][0] + v[j][1] * v[j][1]) + (v[j][2] * v[j][2] + v[j][3] * v[j][3]); }
        ss = wave_sum(ss); const float r = 1.0f / sqrtf(ss * (1.0f / D) + 1e-6f);
#pragma unroll
        for (int j = 0; j < 4; ++j) ((f32x4*)(X + (size_t)row * D))[F.lane + 64 * j] = (v[j] * r) * ((const f32x4*)a.in[I_FINALG])[F.lane + 64 * j];
    }
}
__device__ __forceinline__ void ph_dbgw(const Args& a, const Frame& F) {
    const int gt = F.bid * NTHR + F.tid, NGT = F.G * NTHR; const bf16* w1 = WSP(bf16, WS_WRKV); const bf16* w2 = WSP(bf16, WS_L1T); const bf16* w3 = WSP(bf16, WS_L2T);
    for (size_t i = gt; i < (size_t)M * D; i += NGT) { float v = a.in[I_X][i]; if (i < (size_t)3 * D * D) v += bf2f(w1[i]); if (i < (size_t)768 * D) v += bf2f(w2[i]); if (i < (size_t)3 * D * 256) v += bf2f(w3[i]); a.out[i] = v; }
}
__device__ __forceinline__ void ph_dbg(const Args& a, const Frame& F, const bf16* t1, const bf16* t2, const float* t3, size_t lim1 = (size_t)M * D) {
    const int gt = F.bid * NTHR + F.tid, NGT = F.G * NTHR;
    for (size_t i = gt; i < (size_t)M * D; i += NGT) { float v = a.in[I_X][i]; if (t1 && i < lim1) v += bf2f(t1[i]); if (t2) v += bf2f(t2[i]); if (t3) v += t3[i]; a.out[i] = v; }
}

struct OrderOwn { int pm, z; const char* A; const char* B;
    __device__ __forceinline__ bool next(int i, Unit& u) const { if (i >= 2) return false; u.pm = pm; u.pn = i; u.z = z; u.A = A; u.B = B + (size_t)i * 256 * 256 * 2; return true; } };
__device__ __forceinline__ void ph_cgl(const Args& a, const Frame& F) {
    const bf16* XB = WSP(bf16, A_XB); bf16* XBC = WSP(bf16, A_XBC); const bf16* AT = WSP(bf16, A_AT); const bf16* BT = WSP(bf16, A_BT); float* CAR = WSP(float, A_CAR);
    for (int task = F.bid; task < 256; task += F.G) {
        const int pm = task >> 2, z = task & 3;
        { const int cg = F.tid & 31, rbk = F.tid >> 5, c0 = z * 256 + cg * 8; float wt[4][8], bs[8];
#pragma unroll
          for (int e = 0; e < 8; ++e) bs[e] = a.in[I_CONVB][c0 + e];
#pragma unroll
          for (int j = 0; j < 4; ++j)
#pragma unroll
              for (int e = 0; e < 8; ++e) wt[j][e] = a.in[I_CONVW][j * D + c0 + e];
#pragma unroll 1
          for (int hf = 0; hf < 2; ++hf) { const int R0 = pm * 256 + rbk * 16 + hf * 8, t0 = R0 & (T - 1); u32x4 in[11];
#pragma unroll
              for (int i = 0; i < 11; ++i) { const int rr_ = (t0 - 3 + i >= 0) ? R0 - 3 + i : R0; in[i] = *(const u32x4*)(XB + (size_t)rr_ * D + c0); if (t0 - 3 + i < 0) in[i] = (u32x4){0u, 0u, 0u, 0u}; }
#pragma unroll
              for (int r = 0; r < 8; ++r) { float acc[8];
#pragma unroll
                  for (int e = 0; e < 8; ++e) acc[e] = bs[e];
#pragma unroll
                  for (int j = 0; j < 4; ++j) { float f[8]; unpack8(in[r + j], f);
#pragma unroll
                      for (int e = 0; e < 8; ++e) acc[e] += wt[j][e] * f[e]; }
                  u32x4 w; w.x = cvt_pk_bf16(acc[0], acc[1]); w.y = cvt_pk_bf16(acc[2], acc[3]); w.z = cvt_pk_bf16(acc[4], acc[5]); w.w = cvt_pk_bf16(acc[6], acc[7]);
                  *(u32x4*)(XBC + (size_t)(R0 + r) * D + c0) = w; } } }
        asm volatile("s_waitcnt vmcnt(0)" ::: "memory"); __syncthreads();
        { OrderOwn S{pm, z, (const char*)(XBC + (size_t)pm * 256 * D + z * 256), (const char*)(WSP(bf16, WS_WG) + (size_t)z * 512 * 256)};
          EpiGates E{a.in[I_BGATES], a.in[I_LAM], XBC, WSP(bf16, A_AT), WSP(bf16, A_BT)}; gemm_run(F.lds, GemmDims{256, D, 256}, S, E); }
        asm volatile("s_waitcnt vmcnt(0)" ::: "memory"); __syncthreads();
        { const int chl = F.tid >> 7, c = z * 256 + 2 * (F.tid & 127), row0 = pm * 256 + chl * 64, b = row0 >> 12, ch = (row0 & (T - 1)) >> 6; const size_t off = (size_t)row0 * D + c;
          float P0 = 1.f, P1 = 1.f, h0 = 0.f, h1 = 0.f;
#pragma unroll 1
          for (int tb = 0; tb < 64; tb += 16) { unsigned aw[16], bw[16];
#pragma unroll
              for (int t = 0; t < 16; ++t) { aw[t] = *(const unsigned*)(AT + off + (size_t)(tb + t) * D); bw[t] = *(const unsigned*)(BT + off + (size_t)(tb + t) * D); }
#pragma unroll
              for (int t = 0; t < 16; ++t) { const float a0 = __expf(bf2f(aw[t] & 0xffffu)), a1 = __expf(__uint_as_float(aw[t] & 0xffff0000u)); h0 = a0 * h0 + bf2f(bw[t] & 0xffffu); h1 = a1 * h1 + __uint_as_float(bw[t] & 0xffff0000u); P0 *= a0; P1 *= a1; } }
          *(f32x2*)(CAR + ((size_t)(b * 64 + ch) * 2 + 0) * D + c) = (f32x2){P0, P1}; *(f32x2*)(CAR + ((size_t)(b * 64 + ch) * 2 + 1) * D + c) = (f32x2){h0, h1}; }
        __syncthreads();
    }
}
#if WKV_MODE == 0
#define WKV_PHASES PH_WKV, PH_POST,
#elif WKV_MODE == 1
#define WKV_PHASES PH_WKV, PH_WKV_A, PH_WKV_C,
#else
#define WKV_PHASES PH_WKV_A, PH_WKV_B, PH_WKV_C,
#endif
#if FUSE_MOD
#define MOD1_PHASE
#define MOD2_PHASE
#else
#define MOD1_PHASE PH_MOD1,
#define MOD2_PHASE PH_MOD2,
#endif
enum { PH_PROLOGUE = 0, PH_SHIFT, PH_G_RKV, PH_G_L2, WKV_PHASES PH_G_WO, MOD1_PHASE PH_G_GU, PH_G_DOWN, MOD2_PHASE PH_G_WIN, PH_CGL, PH_LRU2, PH_G_WOUT, PH_R1, PH_R2, PH_G_MGU, PH_G_MD, PH_FINAL, PH_NMAIN, PH_PLAIN_X, PH_PLAIN_OUT, PH_DBG1, PH_DBG2, PH_DBG3, PH_DBG0, PH_DBGW, PH_CONV, PH_G_GATES, PH_LRU1,
#if WKV_MODE == 0
       PH_WKV_A, PH_WKV_B, PH_WKV_C,
#elif WKV_MODE == 1
       PH_WKV_B, PH_POST,
#else
       PH_WKV, PH_POST,
#endif
#if FUSE_MOD
       PH_MOD1, PH_MOD2,
#endif
       PH_COUNT };

template <int PH, bool PROBE_SCRATCH = false>
__device__ __forceinline__ void run_phase(const Args& a, const Frame& F) {
    const float* mod = WSP(float, WS_MOD);
    if constexpr (PH == PH_PROLOGUE) ph_prologue(a, F);
    if constexpr (PH == PH_SHIFT) ph_shift(a, F);
    if constexpr (PH == PH_G_RKV) { OrderRKV S{F.G, F.bid, (const char*)WSP(bf16, A_XM), (const char*)WSP(bf16, WS_WRKV), (const char*)WSP(bf16, WS_L1T)}; EpiRKV E{WSP(bf16, A_RKV), WSP(bf16, A_L1O)};
        gemm_run(F.lds, GemmDims{D, D, D}, S, E); }
    if constexpr (PH == PH_G_L2) { BatchOrder S{64, 4, 3, F.G, F.bid, (const char*)WSP(bf16, A_L1O), (size_t)M * 256 * 2, (size_t)256 * 256 * 2, (const char*)WSP(bf16, WS_L2T), (size_t)D * 256 * 2, (size_t)256 * 256 * 2};
        EpiBf16 E{WSP(bf16, A_L2O), (size_t)M * D, D}; gemm_run(F.lds, GemmDims{256, 256, 256}, S, E); }
    if constexpr (PH == PH_WKV) ph_wkv(a, F);
    if constexpr (PH == PH_WKV_A) ph_wkv_a(a, F);
    if constexpr (PH == PH_WKV_B) ph_wkv_b(a, F);
    if constexpr (PH == PH_WKV_C) ph_wkv_c(a, F);
    if constexpr (PH == PH_LRU1) ph_lru1(a, F);
    if constexpr (PH == PH_LRU2) ph_lru2(a, F);
    if constexpr (PH == PH_POST) ph_post(a, F);
    if constexpr (PH == PH_G_WO) { BatchOrder S{64, 4, 1, F.G, F.bid, (const char*)WSP(bf16, A_YG), 0, (size_t)256 * D * 2, (const char*)WSP(bf16, WS_WO), 0, (size_t)256 * D * 2};
        { EpiResT<float, xres_t> E{a.in[I_X], XRES(a), mod + 0 * 4 * MODW + 2048}; gemm_run(F.lds, GemmDims{D, D, D}, S, E); } }
    if constexpr (PH == PH_MOD1) ph_modulate(a, F, 0, 1, FFN_I8 ? 2 : (FFN_FP8 ? 1 : 0));
#if FFN_I8
    if constexpr (PH == PH_G_GU) { BatchOrder S{64, 28, 1, F.G, F.bid, (const char*)(a.ws + A_H), 0, (size_t)256 * D, (const char*)(a.ws + WS_WGU), 0, (size_t)256 * D};
        EpiGUi8 E{WSP(bf16, A_ACT), WSP(float, WS_SA), (const unsigned*)(a.ws + WS_AMAX)}; gemm_run<EpiGUi8, BatchOrder, 2>(F.lds, GemmDims{D / 2, D / 2, D / 2}, S, E); }
#elif FFN_FP8
    if constexpr (PH == PH_G_GU) { BatchOrder S{64, 28, 1, F.G, F.bid, (const char*)(a.ws + A_H), 0, (size_t)256 * D, (const char*)(a.ws + WS_WGU), 0, (size_t)256 * D};
        EpiGU8 E{a.ws + A_ACT}; gemm_run<EpiGU8, BatchOrder, 1>(F.lds, GemmDims{D / 2, D / 2, D / 2}, S, E); }
#else
    if constexpr (PH == PH_G_GU) { BatchOrder S{64, 28, 1, F.G, F.bid, (const char*)WSP(bf16, A_H), 0, (size_t)256 * D * 2, (const char*)WSP(bf16, WS_WGU), 0, (size_t)256 * D * 2};
        EpiGU E{WSP(bf16, A_ACT)}; gemm_run(F.lds, GemmDims{D, D, D}, S, E); }
#endif
    if constexpr (PH == PH_G_DOWN) { BatchOrder S{64, 4, 1, F.G, F.bid, (const char*)WSP(bf16, A_ACT), 0, (size_t)256 * FF * (FFN_FP8 ? 1 : 2), (const char*)WSP(bf16, WS_WD), 0, (size_t)256 * FF * (FFN_FP8 ? 1 : 2)};
        { EpiResT<xres_t, xres_t> E{XRES(a), PROBE_SCRATCH ? (xres_t*)(a.ws + WS_END) : XRES(a), mod + 0 * 4 * MODW + 5120}; gemm_run<decltype(E), BatchOrder, (FFN_FP8 != 0) ? 1 : 0>(F.lds, FFN_FP8 ? GemmDims{FF / 2, FF / 2, FF / 2} : GemmDims{FF, FF, FF}, S, E); } }
    if constexpr (PH == PH_MOD2) ph_modulate(a, F, 1, 0);
    if constexpr (PH == PH_G_WIN) { BatchOrder S{64, 8, 1, F.G, F.bid, (const char*)WSP(bf16, A_H), 0, (size_t)256 * D * 2, (const char*)WSP(bf16, WS_WIN), 0, (size_t)256 * D * 2};
        EpiWin E{WSP(bf16, A_XB), WSP(bf16, A_GATE)}; gemm_run(F.lds, GemmDims{D, D, D}, S, E); }
    if constexpr (PH == PH_CGL) ph_cgl(a, F);
    if constexpr (PH == PH_CONV) ph_conv(a, F);
    if constexpr (PH == PH_G_GATES) { BatchOrder S{64, 2, 4, F.G, F.bid, (const char*)WSP(bf16, A_XBC), (size_t)256 * 2, (size_t)256 * D * 2, (const char*)WSP(bf16, WS_WG), (size_t)512 * 256 * 2, (size_t)256 * 256 * 2};
        EpiGates E{a.in[I_BGATES], a.in[I_LAM], WSP(bf16, A_XBC), WSP(bf16, A_AT), WSP(bf16, A_BT)}; gemm_run(F.lds, GemmDims{256, D, 256}, S, E); }
    if constexpr (PH == PH_G_WOUT) { BatchOrder S{64, 4, 1, F.G, F.bid, (const char*)WSP(bf16, A_HG), 0, (size_t)256 * D * 2, (const char*)WSP(bf16, WS_WOUT), 0, (size_t)256 * D * 2};
        EpiResT<xres_t, xres_t> E{XRES(a), PROBE_SCRATCH ? (xres_t*)(a.ws + WS_END) : XRES(a), mod + 1 * 4 * MODW + 2048}; gemm_run(F.lds, GemmDims{D, D, D}, S, E); }
    if constexpr (PH == PH_R1) ph_route1(a, F);
    if constexpr (PH == PH_R2) ph_route2(a, F);
#if MOE_FP8
    if constexpr (PH == PH_G_MGU) { MoeOrder S; S.G = F.G; S.c = F.bid; S.nN = 28; S.load(WSP(int, WS_PST), F.lds); S.A = (const char*)(a.ws + A_HS); S.am = (size_t)256 * D; S.B = (const char*)(a.ws + WS_MGU); S.be = (size_t)2 * FF * D; S.bn = (size_t)256 * D;
        EpiGU8 E{a.ws + A_MACT}; gemm_run<EpiGU8, MoeOrder, 1>(F.lds, GemmDims{D / 2, D / 2, D / 2}, S, E); }
    if constexpr (PH == PH_G_MD) { MoeOrder S; S.G = F.G; S.c = F.bid; S.nN = 4; S.load(WSP(int, WS_PST), F.lds); S.A = (const char*)(a.ws + A_MACT); S.am = (size_t)256 * FF; S.B = (const char*)(a.ws + WS_MD); S.be = (size_t)D * FF; S.bn = (size_t)256 * FF;
#if MD_TAIL
        const int units = S.p[8] * 4, L0 = (units / F.G) * F.G, R = units - L0, SP = (R == 0) ? 1 : ((R * 7 <= F.G) ? 7 : ((R * 2 <= F.G) ? 2 : 1)); S.lim = L0;
#endif
        EpiBf16 E{WSP(bf16, A_YD), 0, D}; gemm_run<EpiBf16, MoeOrder, 1>(F.lds, GemmDims{FF / 2, FF / 2, FF / 2}, S, E);
#if MD_TAIL
        if (R > 0) { MoeTail S2{F.bid, 4, S.p, S.A, S.am, S.B, S.be, S.bn, L0, R, SP, (size_t)(FF / SP)}; EpiPart E2{WSP(bf16, A_YDP)};
            gemm_run<EpiPart, MoeTail, 1>(F.lds, GemmDims{FF / 2 / SP, FF / 2, FF / 2}, S2, E2);
            if (F.bid < R * SP) {
                const int s = F.bid / R, j = F.bid - s * R; unsigned* ctl = (unsigned*)(a.ws + WS_CTL);
                if (F.tid == 0) { __builtin_amdgcn_fence(__ATOMIC_RELEASE, "agent"); (void)xb_add(&ctl[CW_TAIL + j], 1u); XB_SPIN(xb_ld(&ctl[CW_TAIL + j]) < (unsigned)SP, ctl + CW_BAR); __builtin_amdgcn_fence(__ATOMIC_ACQUIRE, "agent"); }
                __syncthreads();
                int pm, pn; map_unit(L0 + j, S.p[8], 4, pm, pn);
                const int r0 = s * 256 / SP, r1 = (s + 1) * 256 / SP; const bf16* P = WSP(bf16, A_YDP); bf16* YD = WSP(bf16, A_YD) + (size_t)pm * 256 * D + pn * 256;
                for (int idx = F.tid; idx < (r1 - r0) * 32; idx += NTHR) { const int r = r0 + (idx >> 5), c8 = (idx & 31) * 8; float sum[8] = {0.f, 0.f, 0.f, 0.f, 0.f, 0.f, 0.f, 0.f};
#pragma unroll 1
                    for (int s2 = 0; s2 < SP; ++s2) { float v[8]; unpack8(*(const u32x4*)(P + (size_t)(s2 * R + j) * 65536 + r * 256 + c8), v);
#pragma unroll
                        for (int e = 0; e < 8; ++e) sum[e] += v[e]; }
                    st_bf16x8(YD + (size_t)r * D + c8, (f32x4){sum[0], sum[1], sum[2], sum[3]}, (f32x4){sum[4], sum[5], sum[6], sum[7]}); } } }
#endif
    }
#else
    if constexpr (PH == PH_G_MGU) { MoeOrder S; S.G = F.G; S.c = F.bid; S.nN = 28; S.load(WSP(int, WS_PST), F.lds); S.A = (const char*)WSP(bf16, A_HS); S.am = (size_t)256 * D * 2; S.B = (const char*)WSP(bf16, WS_MGU); S.be = (size_t)2 * FF * D * 2; S.bn = (size_t)256 * D * 2;
        EpiGU E{WSP(bf16, A_MACT)}; gemm_run(F.lds, GemmDims{D, D, D}, S, E); }
    if constexpr (PH == PH_G_MD) { MoeOrder S; S.G = F.G; S.c = F.bid; S.nN = 4; S.load(WSP(int, WS_PST), F.lds); S.A = (const char*)WSP(bf16, A_MACT); S.am = (size_t)256 * FF * 2; S.B = (const char*)WSP(bf16, WS_MD); S.be = (size_t)D * FF * 2; S.bn = (size_t)256 * FF * 2;
        EpiBf16 E{WSP(bf16, A_YD), 0, D}; gemm_run(F.lds, GemmDims{FF, FF, FF}, S, E); }
#endif
    if constexpr (PH == PH_FINAL) ph_final(a, F, PROBE_SCRATCH ? WSP(float, WS_END) : a.out);
    if constexpr (PH == PH_DBG0) ph_dbg(a, F, WSP(bf16, A_XM) + (size_t)5 * M * D, WSP(bf16, A_XM), nullptr);
    if constexpr (PH == PH_DBGW) ph_dbgw(a, F);
    if constexpr (PH == PH_DBG1) ph_dbg(a, F, WSP(bf16, A_L2O), WSP(bf16, A_L2O) + (size_t)M * D, nullptr);
    if constexpr (PH == PH_DBG2) ph_dbg(a, F, nullptr, nullptr, WSP(float, A_Y));
    if constexpr (PH == PH_DBG3) ph_dbg(a, F, WSP(bf16, A_YG), nullptr, nullptr);
    if constexpr (PH == PH_PLAIN_X) ph_final_plain(a, F, a.in[I_X]);
    if constexpr (PH == PH_PLAIN_OUT) ph_final_plain(a, F, a.out);
}

template <int PH>
__global__ void __launch_bounds__(NTHR, 2) k_ph(Args a) {
    __shared__ __attribute__((aligned(16))) unsigned char lds[LDS_BYTES];
    Frame F; F.lds = (LAS unsigned char*)lds; F.tid = threadIdx.x; F.lane = F.tid & 63; F.wave = __builtin_amdgcn_readfirstlane(F.tid >> 6); F.G = gridDim.x; F.bid = blockIdx.x;
    run_phase<PH>(a, F);
}
__device__ __forceinline__ Frame make_frame(LAS unsigned char* lds) {
    int t = threadIdx.x; asm volatile("" : "+v"(t));
    Frame F; F.lds = lds; F.tid = t; F.lane = t & 63; F.wave = __builtin_amdgcn_readfirstlane(t >> 6); F.G = gridDim.x; F.bid = blockIdx.x; return F;
}
template <int PH>
__device__ __forceinline__ void run_all(const Args& a, LAS unsigned char* lds, const XcdBarrier& bar) {
    if constexpr (PH < PH_NMAIN) {
#if defined(PROBE_MASK)
        if constexpr (((PROBE_MASK) >> PH) & 1) {
#pragma unroll 1
            for (int r_ = 0; r_ < PROBE_REP; ++r_) { const Frame Fp = make_frame(lds); run_phase<PH, true>(a, Fp); xcd_barrier(bar); } }
#endif
        { const Frame F = make_frame(lds); run_phase<PH>(a, F); }
        if constexpr (PH + 1 < PH_NMAIN) { xcd_barrier(bar);
#if defined(PROBE_BAR)
            xcd_barrier(bar);
#endif
        }
        run_all<PH + 1>(a, lds, bar); }
}
__global__ void __launch_bounds__(NTHR, 2) k_mega(Args a) {
    __shared__ __attribute__((aligned(16))) unsigned char lds[LDS_BYTES];
    Frame F; F.lds = (LAS unsigned char*)lds; F.tid = threadIdx.x; F.lane = F.tid & 63; F.wave = __builtin_amdgcn_readfirstlane(F.tid >> 6); F.G = gridDim.x; F.bid = blockIdx.x;
    volatile LAS unsigned* misc = (volatile LAS unsigned*)(F.lds + MISC_OFF);
    if (F.tid < 16) misc[F.tid] = 0u;
    __syncthreads();
    const XcdBarrier bar = xcd_barrier_post((unsigned*)(a.ws + WS_CTL) + CW_BAR, misc + 8);
    run_all<0>(a, F.lds, bar);
}
template <int PH>
static void launch_all(const Args& a, hipStream_t stream) {
    if constexpr (PH < PH_NMAIN) { hipLaunchKernelGGL(k_ph<PH>, dim3(256), dim3(NTHR), 0, stream, a); launch_all<PH + 1>(a, stream); }
}
#ifndef MEGA
#define MEGA 1
#endif
extern "C" void kernel_launch(void* const* d_in, const int* in_sizes, int n_in, void* d_out, int out_size, void* d_ws, size_t ws_size, hipStream_t stream) {
    if (n_in != 35 || out_size != M * D || ws_size < WS_END) { fprintf(stderr, "kernel_launch: unexpected shapes (n_in %d, out %d, ws %zu, need %zu)\n", n_in, out_size, ws_size, (size_t)WS_END); return; }
    Args a{};
    for (int i = 0; i < 35; ++i) a.in[i] = (const float*)d_in[i];
    a.out = (float*)d_out; a.ws = (unsigned char*)d_ws;
    (void)hipMemsetAsync((char*)d_ws + WS_CTL, 0, CTL_ZERO_BYTES, stream);
#if MEGA
    hipLaunchKernelGGL(k_mega, dim3(256), dim3(NTHR), 0, stream, a);
#else
    launch_all<0>(a, stream);
#endif
}
```

```cpp
#include <hip/hip_runtime.h>
#include <cstdio>
#include <cstdint>

#define GAS __attribute__((address_space(1)))
#define LAS __attribute__((address_space(3)))
typedef unsigned short bf16;
typedef short bf16x8 __attribute__((ext_vector_type(8)));
typedef float f32x4 __attribute__((ext_vector_type(4)));
typedef float f32x2 __attribute__((ext_vector_type(2)));
typedef unsigned u32x4 __attribute__((ext_vector_type(4)));
typedef unsigned u32x2 __attribute__((ext_vector_type(2)));
typedef int i32x2 __attribute__((ext_vector_type(2)));

#ifndef PROBE_REP
#define PROBE_REP 1
#endif
#ifndef WKV_MODE
#define WKV_MODE 2
#endif
#ifndef MOE_FP8
#define MOE_FP8 1
#endif
#ifndef FFN_I8
#define FFN_I8 1
#endif
#ifndef MD_TAIL
#define MD_TAIL 1
#endif
#ifndef FFN_FP8
#define FFN_FP8 0
#endif
#ifndef X_BF16
#define X_BF16 1
#endif
#ifndef FUSE_MOD
#define FUSE_MOD 0
#endif
#ifndef STAGE
#define STAGE 4
#endif
#ifndef FAST_GEMM
#define FAST_GEMM 1
#endif

constexpr int NB = 4, T = 4096, D = 1024, M = NB * T, NH = 16, HS = 64, FF = 3584, NE = 8;
constexpr int MODW = 6 * D;
constexpr int MPAD = 2 * M + NE * 256;
constexpr int NWAVES = 8, NTHR = 512;

constexpr size_t MiB = 1u << 20;
constexpr size_t WS_CTL = 0, CTL_ZERO_BYTES = 64 * 1024;
constexpr size_t WS_MOD = 1 * MiB;
constexpr size_t WS_CNT = 1 * MiB + 256 * 1024;
constexpr size_t WS_PST = WS_CNT + 16 * 1024;
constexpr size_t WS_SEL = 2 * MiB;
constexpr size_t WS_PROB = WS_SEL + 128 * 1024;
constexpr size_t WS_POS = WS_PROB + 128 * 1024;
constexpr size_t WS_XSL = 3 * MiB;
constexpr int CW_SEAM = 16384;
constexpr size_t WS_SA = 3 * MiB + 512 * 1024;
constexpr size_t WS_AMAX = WS_CTL + 32;
__device__ unsigned g_ctl[CTL_ZERO_BYTES / 4];
#define CTLP ((unsigned char*)g_ctl)
constexpr size_t WS_WRKV = 4 * MiB, WS_L1T = 10 * MiB, WS_L2T = 12 * MiB, WS_WO = 14 * MiB, WS_WGU = 16 * MiB, WS_WD = 30 * MiB;
constexpr size_t WS_WIN = 37 * MiB, WS_WG = 41 * MiB, WS_WOUT = 42 * MiB, WS_MGU = 44 * MiB, WS_MD = 156 * MiB, WS_ARENA = 212 * MiB;
constexpr size_t A_XM = WS_ARENA, A_RKV = WS_ARENA + 192 * MiB, A_L1O = WS_ARENA + 288 * MiB, A_L2O = WS_ARENA + 312 * MiB, A_Y = WS_ARENA + 408 * MiB, A_YG = WS_ARENA + 472 * MiB;
constexpr size_t A_H = WS_ARENA, A_ACT = WS_ARENA + 32 * MiB;
constexpr size_t A_XB = WS_ARENA + 32 * MiB, A_GATE = WS_ARENA + 64 * MiB, A_XBC = WS_ARENA + 96 * MiB, A_AT = WS_ARENA + 128 * MiB, A_BT = WS_ARENA + 192 * MiB, A_HG = WS_ARENA + 256 * MiB, A_CAR = WS_ARENA + 288 * MiB;
constexpr size_t A_HS = WS_ARENA + 32 * MiB, A_MACT = WS_ARENA + 100 * MiB, A_YD = WS_ARENA + 338 * MiB;
constexpr size_t A_YDP = WS_ARENA + 408 * MiB;
constexpr int CW_BAR = 4096;
constexpr int CW_TAIL = 64;
constexpr size_t WS_X16 = WS_ARENA + 504 * MiB;
constexpr size_t WS_END = WS_ARENA + 536 * MiB;
static_assert(A_HS + (size_t)MPAD * D * 2 <= A_MACT && A_MACT + (size_t)MPAD * FF * 2 <= A_YD && A_YD + (size_t)MPAD * D * 4 <= WS_END, "moe arena");

constexpr int LDS_BYTES = 147456;
constexpr int RING_BYTES = 131072;
constexpr int MISC_OFF = LDS_BYTES - 512;

struct Args {
    const float* in[35];
    float* out;
    unsigned char* ws;
};
enum { I_X = 0, I_C, I_ADAW, I_ADAB, I_NORMG, I_FINALG, I_MU, I_WRKV, I_WO, I_W0, I_W1, I_W2, I_A0, I_A1, I_A2, I_G1, I_G2, I_KK, I_KA, I_RK, I_GNW, I_GNB,
       I_WIN, I_CONVW, I_CONVB, I_WGATES, I_BGATES, I_LAM, I_WOUT, I_FGU, I_FD, I_ROUTW, I_ROUTB, I_MGU, I_MD };

__device__ __forceinline__ float bf2f(unsigned v) { return __uint_as_float(v << 16); }
typedef __bf16 bf16x2_t __attribute__((ext_vector_type(2)));
__device__ __forceinline__ unsigned cvt_pk_bf16(float lo, float hi) { const f32x2 v = {lo, hi}; const bf16x2_t b = __builtin_convertvector(v, bf16x2_t); return __builtin_bit_cast(unsigned, b); }
__device__ __forceinline__ u32x2 pk4(const f32x4 v) { u32x2 w; w.x = cvt_pk_bf16(v[0], v[1]); w.y = cvt_pk_bf16(v[2], v[3]); return w; }
__device__ __forceinline__ f32x4 unpk4(const u32x2 w) { return (f32x4){bf2f(w.x & 0xffffu), __uint_as_float(w.x & 0xffff0000u), bf2f(w.y & 0xffffu), __uint_as_float(w.y & 0xffff0000u)}; }
__device__ __forceinline__ unsigned pk_fp8x4(float a, float b, float c, float d) { int w = __builtin_amdgcn_cvt_pk_fp8_f32(a, b, 0, false); w = __builtin_amdgcn_cvt_pk_fp8_f32(c, d, w, true); return (unsigned)w; }
constexpr float F8_WSCALE = 64.0f;
#if X_BF16
typedef bf16 xres_t;
__device__ __forceinline__ f32x4 xload4(const xres_t* row, int idx4) { return unpk4(((const u32x2*)row)[idx4]); }
__device__ __forceinline__ void xstore4(xres_t* p, const f32x4 v) { *(u32x2*)p = pk4(v); }
#else
typedef float xres_t;
__device__ __forceinline__ f32x4 xload4(const xres_t* row, int idx4) { return ((const f32x4*)row)[idx4]; }
__device__ __forceinline__ void xstore4(xres_t* p, const f32x4 v) { *(f32x4*)p = v; }
#endif
#define XRES(a) (X_BF16 ? (xres_t*)((a).ws + WS_X16) : (xres_t*)(a).out)
template <class TX> __device__ __forceinline__ f32x4 ld4any(const TX* row, int idx4);
template <> __device__ __forceinline__ f32x4 ld4any<float>(const float* row, int idx4) { return ((const f32x4*)row)[idx4]; }
template <> __device__ __forceinline__ f32x4 ld4any<bf16>(const bf16* row, int idx4) { return unpk4(((const u32x2*)row)[idx4]); }
__device__ __forceinline__ float dppx(float x, const int sel) {
    const int xi = __builtin_bit_cast(int, x); int r;
    if (sel == 0) r = __builtin_amdgcn_update_dpp(0, xi, 0xB1, 0xF, 0xF, true); else if (sel == 1) r = __builtin_amdgcn_update_dpp(0, xi, 0x4E, 0xF, 0xF, true);
    else if (sel == 2) r = __builtin_amdgcn_update_dpp(0, xi, 0x141, 0xF, 0xF, true); else r = __builtin_amdgcn_update_dpp(0, xi, 0x140, 0xF, 0xF, true);
    return __builtin_bit_cast(float, r);
}
__device__ __forceinline__ float rlane(float v, int l) { return __builtin_bit_cast(float, __builtin_amdgcn_readlane(__builtin_bit_cast(int, v), l)); }
__device__ __forceinline__ float wave_sum(float v) { v += dppx(v, 0); v += dppx(v, 1); v += dppx(v, 2); v += dppx(v, 3); return (rlane(v, 0) + rlane(v, 16)) + (rlane(v, 32) + rlane(v, 48)); }
__device__ __forceinline__ float wave_max(float v) { v = fmaxf(v, dppx(v, 0)); v = fmaxf(v, dppx(v, 1)); v = fmaxf(v, dppx(v, 2)); v = fmaxf(v, dppx(v, 3)); return fmaxf(fmaxf(rlane(v, 0), rlane(v, 16)), fmaxf(rlane(v, 32), rlane(v, 48))); }
__device__ __forceinline__ float sigmoidf_(float x) { return __builtin_amdgcn_rcpf(1.0f + __expf(-x)); }
__device__ __forceinline__ float softplusf_(float z) { return fmaxf(z, 0.f) + __logf(1.0f + __expf(-fabsf(z))); }
__device__ __forceinline__ float siluf_(float x) { return x * __builtin_amdgcn_rcpf(1.0f + __expf(-x)); }
__device__ __forceinline__ float tanhf_(float x) { return 1.0f - 2.0f * __builtin_amdgcn_rcpf(__expf(2.0f * x) + 1.0f); }
__device__ __forceinline__ float gelu_tanh(float x) { const float u = 0.7978845608028654f * (x + 0.044715f * x * x * x); return 0.5f * x * (1.0f + tanhf_(u)); }
__device__ __forceinline__ void unpack8(const u32x4 w, float (&f)[8]) {
    f[0] = bf2f(w.x & 0xffffu); f[1] = __uint_as_float(w.x & 0xffff0000u); f[2] = bf2f(w.y & 0xffffu); f[3] = __uint_as_float(w.y & 0xffff0000u);
    f[4] = bf2f(w.z & 0xffffu); f[5] = __uint_as_float(w.z & 0xffff0000u); f[6] = bf2f(w.w & 0xffffu); f[7] = __uint_as_float(w.w & 0xffff0000u);
}

constexpr int BM = 256, BK = 64, HALF = 128, HTB = HALF * BK * 2, NXCD = 8, WGM = 8;
struct Unit { int pm, pn, z; const char* A; const char* B; };
struct GemmDims { int K, lda, ldb; };

__device__ __forceinline__ void map_unit(int L, int nM, int nN, int& pm, int& pn) {
    const int nwg = nM * nN; int wgid = L;
    { const int q = nwg / NXCD, r = nwg % NXCD, xcd = wgid % NXCD, off = wgid / NXCD; wgid = (xcd < r ? xcd * (q + 1) : r * (q + 1) + (xcd - r) * q) + off; }
    const int nig = WGM * nN, gid = wgid / nig, fm = gid * WGM, gsz = (nM - fm) < WGM ? (nM - fm) : WGM;
    pm = __builtin_amdgcn_readfirstlane(fm + ((wgid % nig) % gsz)); pn = __builtin_amdgcn_readfirstlane((wgid % nig) / gsz);
}
struct BatchOrder {
    int nM, nN, nz, G, c; const char* A; size_t az, am; const char* B; size_t bz, bn;
    __device__ __forceinline__ bool next(int i, Unit& u) const {
        const int L = i * G + c, per = nM * nN; if (L >= per * nz) return false;
        const int z = L / per; int pm, pn; map_unit(L - z * per, nM, nN, pm, pn);
        u.pm = pm; u.pn = pn; u.z = z; u.A = A + z * az + pm * am; u.B = B + z * bz + pn * bn; return true;
    }
};
struct OrderRKV {
    int G, c; const char* XM; const char* WR; const char* L1T;
    __device__ __forceinline__ bool next(int i, Unit& u) const {
        const int L = i * G + c; if (L >= 960) return false;
        if (L < 768) { const int z = L >> 8, r = L & 255, x = r & 7, y = r >> 3; u.pm = 8 * x + (y >> 2); u.pn = y & 3; u.z = z;
            u.A = XM + ((size_t)z * M + (size_t)u.pm * 256) * (D * 2); u.B = WR + ((size_t)z * D + (size_t)u.pn * 256) * (D * 2); }
        else { const int j = L - 768, q = j >> 6; u.pm = j & 63; u.pn = 0; u.z = 3 + q;
            u.A = XM + ((size_t)(3 + q) * M + (size_t)u.pm * 256) * (D * 2); u.B = L1T + (size_t)q * 256 * (D * 2); }
        return true;
    }
};
struct MoeOrder {
    int G, c, nN; const LAS int* p; const char* A; size_t am; const char* B; size_t be, bn; int lim = 0x7fffffff;
    __device__ __forceinline__ void load(const int* pst, LAS unsigned char* lds) {
        LAS int* t = (LAS int*)(lds + MISC_OFF + 128);
        if (threadIdx.x < 9) t[threadIdx.x] = pst[threadIdx.x] >> 8;
        __syncthreads(); p = t;
    }
    __device__ __forceinline__ bool next(int i, Unit& u) const {
        const int nM = __builtin_amdgcn_readfirstlane(p[8]), L = i * G + c; if (L >= nM * nN || L >= lim) return false;
        int pm, pn; map_unit(L, nM, nN, pm, pn);
        int e = 0;
#pragma unroll
        for (int k = 1; k < 8; ++k) e += (pm >= __builtin_amdgcn_readfirstlane(p[k])) ? 1 : 0;
        u.pm = pm; u.pn = pn; u.z = e; u.A = A + pm * am; u.B = B + e * be + pn * bn; return true;
    }
};

struct MoeTail {
    int c, nN; const LAS int* p; const char* A; size_t am; const char* B; size_t be, bn; int L0, R, S; size_t ksub;
    __device__ __forceinline__ bool next(int i, Unit& u) const {
        if (i > 0 || c >= R * S) return false;
        const int s = c / R, j = c - s * R, nM = __builtin_amdgcn_readfirstlane(p[8]); int pm, pn; map_unit(L0 + j, nM, nN, pm, pn);
        int e = 0;
#pragma unroll
        for (int k = 1; k < 8; ++k) e += (pm >= __builtin_amdgcn_readfirstlane(p[k])) ? 1 : 0;
        u.pm = pm; u.pn = pn; u.z = c; u.A = A + pm * am + s * ksub; u.B = B + e * be + pn * bn + s * ksub; return true;
    }
};

template <class Epi, class Sched>
__device__ __forceinline__ void gemm_simple(const GemmDims g, const Sched& S, const Epi& E) {
    const int tid = threadIdx.x, wid = __builtin_amdgcn_readfirstlane(tid >> 6), lane = tid & 63, wr = wid >> 2, wc = wid & 3, fr = lane & 15, fq = lane >> 4;
    Unit u;
    for (int i = 0; S.next(i, u); ++i) {
        f32x4 acc[2][2][4][2];
#pragma unroll
        for (int a = 0; a < 2; ++a)
#pragma unroll
            for (int b = 0; b < 2; ++b)
#pragma unroll
                for (int m = 0; m < 4; ++m)
#pragma unroll
                    for (int n = 0; n < 2; ++n) acc[a][b][m][n] = (f32x4){0.f, 0.f, 0.f, 0.f};
        const char* pa = u.A + ((size_t)(wr * 64 + fr) * g.lda + fq * 8) * 2;
        const char* pb = u.B + ((size_t)(wc * 32 + fr) * g.ldb + fq * 8) * 2;
#pragma unroll 1
        for (int k0 = 0; k0 < g.K; k0 += 32) {
            bf16x8 af[2][4], bfr[2][2];
#pragma unroll
            for (int ai = 0; ai < 2; ++ai)
#pragma unroll
                for (int m = 0; m < 4; ++m) af[ai][m] = *(const bf16x8*)(pa + ((size_t)(ai * 128 + m * 16) * g.lda + k0) * 2);
#pragma unroll
            for (int bj = 0; bj < 2; ++bj)
#pragma unroll
                for (int n = 0; n < 2; ++n) bfr[bj][n] = *(const bf16x8*)(pb + ((size_t)(bj * 128 + n * 16) * g.ldb + k0) * 2);
#pragma unroll
            for (int ai = 0; ai < 2; ++ai)
#pragma unroll
                for (int bj = 0; bj < 2; ++bj)
#pragma unroll
                    for (int m = 0; m < 4; ++m)
#pragma unroll
                        for (int n = 0; n < 2; ++n) acc[ai][bj][m][n] = __builtin_amdgcn_mfma_f32_16x16x32_bf16(bfr[bj][n], af[ai][m], acc[ai][bj][m][n], 0, 0, 0);
        }
        E(acc, u, wr, wc, fr, fq);
    }
}

__host__ __device__ __forceinline__ int lds_byte(int r, int c) { const int st = (r >> 4) * 2 + (c >> 5), rr = r & 15, cc = c & 31, ob = rr * 64 + cc * 2; return st * 1024 + (ob ^ (((ob >> 9) & 1) << 5)); }
__host__ __device__ __forceinline__ void stage_rc(int b, int& R, int& C) { const int st = b / 1024, sb = b % 1024, swz = sb ^ (((sb >> 9) & 1) << 5); R = (st >> 1) * 16 + swz / 64; C = (st & 1) * 32 + (swz % 64) / 2; }

__device__ __forceinline__ const char* uptr(const char* p) { const unsigned long long v = (unsigned long long)p; const unsigned lo = __builtin_amdgcn_readfirstlane((unsigned)v), hi = __builtin_amdgcn_readfirstlane((unsigned)(v >> 32)); return (const char*)(((unsigned long long)hi << 32) | lo); }
__device__ __forceinline__ void unit_uniform(Unit& u) { u.pm = __builtin_amdgcn_readfirstlane(u.pm); u.pn = __builtin_amdgcn_readfirstlane(u.pn); u.z = __builtin_amdgcn_readfirstlane(u.z); u.A = uptr(u.A); u.B = uptr(u.B); }
typedef int i32x4v __attribute__((ext_vector_type(4)));
typedef int i32x8v __attribute__((ext_vector_type(8)));
__device__ __forceinline__ i32x8v cat8(const bf16x8 lo, const bf16x8 hi) { const i32x4v a = __builtin_bit_cast(i32x4v, lo), b = __builtin_bit_cast(i32x4v, hi); return __builtin_shufflevector(a, b, 0, 1, 2, 3, 4, 5, 6, 7); }
template <class Epi, class Sched, int QM = 0>
__device__ __forceinline__ void gemm_phase(LAS unsigned char* lds, const GemmDims g, const Sched& S, const Epi& E) {
    int tid_ = threadIdx.x; asm volatile("" : "+v"(tid_));
    const int tid = tid_, wid = __builtin_amdgcn_readfirstlane(tid >> 6), lane = tid & 63, wr = wid >> 2, wc = wid & 3, fr = lane & 15, fq = lane >> 4;
    const int nt = g.K / BK;
    unsigned voffA[2], voffB[2];
#pragma unroll
    for (int i = 0; i < 2; ++i) { int R, C; stage_rc(tid * 16 + i * 8192, R, C); voffA[i] = (unsigned)(R * g.lda + C) * 2u; voffB[i] = (unsigned)(R * g.ldb + C) * 2u; }
    const size_t kstep = (size_t)(BK * 2);
    const size_t hstepA = (size_t)HALF * g.lda * 2, hstepB = (size_t)HALF * g.ldb * 2;
    const unsigned ldsw = (unsigned)wid * 1024u;
    const int aoff = lds_byte(wr * 64 + fr, fq * 8), boff = lds_byte(wc * 32 + fr, fq * 8);
#define PG8_SA(b, h) (((b) * 2 + (h)) * HTB)
#define PG8_SB(b, h) ((4 + (b) * 2 + (h)) * HTB)
#define PG8_STAGE(bufoff, gbase, voff) do { _Pragma("unroll") for (int _i = 0; _i < 2; ++_i) \
        __builtin_amdgcn_global_load_lds((const unsigned*)((const char*)(gbase) + (voff)[_i]), (LAS unsigned*)(lds + (bufoff) + ldsw + _i * 8192), 16, 0, 0); } while (0)
#define PG8_LD8(p) __builtin_shufflevector(*(const LAS i32x4v*)(p), *(const LAS i32x4v*)((p) + 1024), 0, 1, 2, 3, 4, 5, 6, 7)
    LAS unsigned char* pA_ = lds + aoff; LAS unsigned char* pB_ = lds + 4 * HTB + boff; asm volatile("" : "+v"(pA_), "+v"(pB_));
#define PG8_LDA(dst, b, h) do { _Pragma("unroll") for (int m = 0; m < 4; ++m) dst[m] = PG8_LD8(pA_ + PG8_SA(b, h) + m * 2048); } while (0)
#define PG8_LDB(dst, b, h) do { _Pragma("unroll") for (int n = 0; n < 2; ++n) dst[n] = PG8_LD8(pB_ + (PG8_SB(b, h) - 4 * HTB) + n * 2048); } while (0)
#define PG8_LO(v) __builtin_bit_cast(bf16x8, __builtin_shufflevector(v, v, 0, 1, 2, 3))
#define PG8_HI(v) __builtin_bit_cast(bf16x8, __builtin_shufflevector(v, v, 4, 5, 6, 7))
#define PG8_MMA(ai, bj, At, Bt) do { __builtin_amdgcn_s_setprio(1); _Pragma("unroll") for (int m = 0; m < 4; ++m) _Pragma("unroll") for (int n = 0; n < 2; ++n) { \
        if constexpr (QM == 1) asm volatile("v_mfma_scale_f32_16x16x128_f8f6f4 %0, %1, %2, %0, %3, %4 op_sel_hi:[0,0,0]" : "+v"(acc[ai][bj][m][n]) : "v"(Bt[n]), "v"(At[m]), "v"(f8_sw), "v"(f8_sa));   \
        else if constexpr (QM == 2) { i32x4v c_ = __builtin_bit_cast(i32x4v, acc[ai][bj][m][n]); c_ = __builtin_amdgcn_mfma_i32_16x16x64_i8(__builtin_shufflevector(Bt[n], Bt[n], 0, 1, 2, 3), __builtin_shufflevector(At[m], At[m], 0, 1, 2, 3), c_, 0, 0, 0); \
            c_ = __builtin_amdgcn_mfma_i32_16x16x64_i8(__builtin_shufflevector(Bt[n], Bt[n], 4, 5, 6, 7), __builtin_shufflevector(At[m], At[m], 4, 5, 6, 7), c_, 0, 0, 0); acc[ai][bj][m][n] = __builtin_bit_cast(f32x4, c_); } \
        else { acc[ai][bj][m][n] = __builtin_amdgcn_mfma_f32_16x16x32_bf16(PG8_LO(Bt[n]), PG8_LO(At[m]), acc[ai][bj][m][n], 0, 0, 0); acc[ai][bj][m][n] = __builtin_amdgcn_mfma_f32_16x16x32_bf16(PG8_HI(Bt[n]), PG8_HI(At[m]), acc[ai][bj][m][n], 0, 0, 0); } } __builtin_amdgcn_s_setprio(0); } while (0)
#define PG8_WAIT_V(n) asm volatile("s_waitcnt vmcnt(" #n ")" ::: "memory")
#define PG8_WAIT_L(n) asm volatile("s_waitcnt lgkmcnt(" #n ")" ::: "memory")
#define PG8_BAR __builtin_amdgcn_s_barrier()
#define PG8_SCHED __builtin_amdgcn_sched_barrier(0)
    Unit cur, nxt; int ui = 0;
    if (!S.next(0, cur)) return;
    unit_uniform(cur);
    f32x4 acc[2][2][4][2];
#pragma unroll
    for (int a = 0; a < 2; ++a)
#pragma unroll
        for (int b = 0; b < 2; ++b)
#pragma unroll
            for (int m = 0; m < 4; ++m)
#pragma unroll
                for (int n = 0; n < 2; ++n) acc[a][b][m][n] = (f32x4){0.f, 0.f, 0.f, 0.f};
    i32x8v At[4], B0[2], B1[2];
    const int f8_sw = 0x79797979, f8_sa = 0x7F7F7F7F;
    const char* cA = cur.A; const char* cB = cur.B;
    PG8_STAGE(PG8_SB(0, 0), cB, voffB); PG8_STAGE(PG8_SB(0, 1), cB + hstepB, voffB); PG8_STAGE(PG8_SA(0, 0), cA, voffA); PG8_STAGE(PG8_SA(0, 1), cA + hstepA, voffA);
    if (wr == 1) PG8_BAR;
    PG8_WAIT_V(2); PG8_BAR;
    PG8_STAGE(PG8_SB(1, 0), cB + kstep, voffB); PG8_STAGE(PG8_SA(1, 0), cA + kstep, voffA); PG8_STAGE(PG8_SB(1, 1), cB + hstepB + kstep, voffB);
    PG8_WAIT_V(6); PG8_BAR;
    for (;;) {
        const bool has_next = S.next(ui + 1, nxt); if (has_next) unit_uniform(nxt);
        const char* nA = has_next ? nxt.A : cA; const char* nB = has_next ? nxt.B : cB;
#pragma unroll 1
        for (int t = 0; t < nt; t += 2) {
            const bool last = (t == nt - 2);
            const char* a1 = cA + (size_t)(t + 1) * kstep;
            const char* a2 = last ? nA : cA + (size_t)(t + 2) * kstep; const char* b2 = last ? nB : cB + (size_t)(t + 2) * kstep;
            const char* a3 = a2 + kstep; const char* b3 = b2 + kstep;
            PG8_LDB(B0, 0, 0); PG8_LDB(B1, 0, 1); PG8_SCHED; PG8_LDA(At, 0, 0); PG8_STAGE(PG8_SA(1, 1), a1 + hstepA, voffA);
            PG8_WAIT_V(8); PG8_WAIT_L(0); PG8_BAR; PG8_MMA(0, 0, At, B0); PG8_MMA(0, 1, At, B1); PG8_BAR; PG8_SCHED;
            PG8_LDA(At, 0, 1); PG8_STAGE(PG8_SB(0, 0), b2, voffB); PG8_STAGE(PG8_SB(0, 1), b2 + hstepB, voffB); PG8_STAGE(PG8_SA(0, 0), a2, voffA);
            PG8_WAIT_V(8); PG8_WAIT_L(0); PG8_BAR; PG8_MMA(1, 0, At, B0); PG8_MMA(1, 1, At, B1); PG8_BAR; PG8_SCHED;
            PG8_LDB(B0, 1, 0); PG8_LDB(B1, 1, 1); PG8_SCHED; PG8_LDA(At, 1, 0); PG8_STAGE(PG8_SA(0, 1), a2 + hstepA, voffA);
            PG8_WAIT_V(8); PG8_WAIT_L(0); PG8_BAR; PG8_MMA(0, 0, At, B0); PG8_MMA(0, 1, At, B1); PG8_BAR; PG8_SCHED;
            PG8_LDA(At, 1, 1); PG8_STAGE(PG8_SB(1, 0), b3, voffB); PG8_STAGE(PG8_SB(1, 1), b3 + hstepB, voffB); PG8_STAGE(PG8_SA(1, 0), a3, voffA);
            PG8_WAIT_V(8); PG8_WAIT_L(0); PG8_BAR; PG8_MMA(1, 0, At, B0); PG8_MMA(1, 1, At, B1); PG8_BAR; PG8_SCHED;
        }
        if (wr == 0) PG8_BAR;
        if constexpr (QM == 1) asm volatile("s_nop 15\n\ts_nop 15\n\ts_nop 15" ::: "memory");
        { int te = threadIdx.x; asm volatile("" : "+v"(te));
          const int le = te & 63, we = __builtin_amdgcn_readfirstlane(te >> 6); E(acc, cur, we >> 2, we & 3, le & 15, le >> 4); }
        if (!has_next) break;
#pragma unroll
        for (int a = 0; a < 2; ++a)
#pragma unroll
            for (int b = 0; b < 2; ++b)
#pragma unroll
                for (int m = 0; m < 4; ++m)
#pragma unroll
                    for (int n = 0; n < 2; ++n) acc[a][b][m][n] = (f32x4){0.f, 0.f, 0.f, 0.f};
        cur = nxt; cA = nA; cB = nB; ++ui;
        if (wr == 1) PG8_BAR;
    }
    PG8_WAIT_V(0);
    PG8_BAR;
#undef PG8_SA
#undef PG8_SB
#undef PG8_STAGE
#undef PG8_LDA
#undef PG8_LDB
#undef PG8_LD8
#undef PG8_LO
#undef PG8_HI
#undef PG8_MMA
#undef PG8_WAIT_V
#undef PG8_WAIT_L
#undef PG8_BAR
#undef PG8_SCHED
}

template <class Epi, class Sched, int QM = 0>
__device__ __forceinline__ void gemm_run(LAS unsigned char* lds, const GemmDims g, const Sched& S, const Epi& E) {
#if FAST_GEMM
    gemm_phase<Epi, Sched, QM>(lds, g, S, E);
#else
    gemm_simple<Epi, Sched>(g, S, E);
#endif
}

#define EPI_ARGS const f32x4 (&acc)[2][2][4][2], const Unit& u, int wr, int wc, int fr, int fq
#define ROWS_LOOP _Pragma("unroll") for (int ai = 0; ai < 2; ++ai) _Pragma("unroll") for (int m = 0; m < 4; ++m)
#define COLS_LOOP _Pragma("unroll") for (int bj = 0; bj < 2; ++bj) _Pragma("unroll") for (int n = 0; n < 2; ++n)
__device__ __forceinline__ void st_bf16x4(bf16* p, const f32x4 v) { u32x2 w; w.x = cvt_pk_bf16(v[0], v[1]); w.y = cvt_pk_bf16(v[2], v[3]); *(u32x2*)p = w; }

__host__ __device__ __forceinline__ int slot32(int c) { return 16 * ((c >> 2) & 1) + 4 * (c >> 3) + (c & 3); }
#define BJ_LOOP _Pragma("unroll") for (int bj = 0; bj < 2; ++bj)
__device__ __forceinline__ void st_bf16x8(bf16* p, const f32x4 a, const f32x4 b) { u32x4 w; w.x = cvt_pk_bf16(a[0], a[1]); w.y = cvt_pk_bf16(a[2], a[3]); w.z = cvt_pk_bf16(b[0], b[1]); w.w = cvt_pk_bf16(b[2], b[3]); *(u32x4*)p = w; }
typedef float f32x2p __attribute__((ext_vector_type(2)));
#define P2LO(v) __builtin_shufflevector(v, v, 0, 1)
#define P2HI(v) __builtin_shufflevector(v, v, 2, 3)
#define P2CAT(a, b) __builtin_shufflevector(a, b, 0, 1, 2, 3)
__device__ __forceinline__ f32x2p exp2_2(const f32x2p t) { f32x2p e; e.x = __builtin_amdgcn_exp2f(t.x); e.y = __builtin_amdgcn_exp2f(t.y); return e; }
__device__ __forceinline__ f32x2p rcp_2(const f32x2p t) { f32x2p e; e.x = __builtin_amdgcn_rcpf(t.x); e.y = __builtin_amdgcn_rcpf(t.y); return e; }
__device__ __forceinline__ f32x2p sigmoid2(const f32x2p x) { return rcp_2(exp2_2(x * -1.4426950408889634f) + 1.0f); }
__device__ __forceinline__ f32x2p tanh2(const f32x2p x) { const f32x2p r = rcp_2(exp2_2(x * 2.8853900817779268f) + 1.0f); return r * -2.0f + 1.0f; }
__device__ __forceinline__ f32x2p gelu2(const f32x2p x) {
    const f32x2p in = x * (x * x * 0.044715f + 1.0f); const f32x2p r = rcp_2(exp2_2(in * (2.0f * 0.7978845608028654f * 1.4426950408889634f)) + 1.0f); return x - x * r; }
__device__ __forceinline__ f32x2p silu_mul2(const f32x2p g, const f32x2p u) { return (g * u) * sigmoid2(g); }
__device__ __forceinline__ f32x4 silu_mul4(const f32x4 g, const f32x4 u) { return P2CAT(silu_mul2(P2LO(g), P2LO(u)), silu_mul2(P2HI(g), P2HI(u))); }
__device__ __forceinline__ f32x4 act4(const f32x4 v, int kind) { f32x4 o = v;
    if (kind == 1) o = P2CAT(tanh2(P2LO(v)), tanh2(P2HI(v)));
    if (kind == 2) o = P2CAT(sigmoid2(P2LO(v)), sigmoid2(P2HI(v)));
    if (kind == 3) o = P2CAT(gelu2(P2LO(v)), gelu2(P2HI(v)));
    return o; }
struct EpiRKV {
    bf16* RKV; bf16* L1O;
    __device__ __forceinline__ void operator()(EPI_ARGS) const {
        const int row0 = u.pm * 256 + wr * 64 + fr, col0 = wc * 32 + fq * 8;
        if (u.z < 3) {
            bf16* base = RKV + ((size_t)u.z * M) * D + u.pn * 256 + col0;
            ROWS_LOOP { bf16* rp = base + (size_t)(row0 + ai * 128 + m * 16) * D; BJ_LOOP st_bf16x8(rp + bj * 128, acc[ai][bj][m][0], acc[ai][bj][m][1]); }
        } else {
            const int q = u.z - 3, kind = (q == 0) ? 1 : ((q == 2) ? 2 : 0); bf16* base = L1O + ((size_t)q * M) * 256 + col0;
            ROWS_LOOP { bf16* rp = base + (size_t)(row0 + ai * 128 + m * 16) * 256; BJ_LOOP st_bf16x8(rp + bj * 128, act4(acc[ai][bj][m][0], kind), act4(acc[ai][bj][m][1], kind)); }
        }
    }
};
struct EpiBf16 {
    bf16* O; size_t zstride; int ldo;
    __device__ __forceinline__ void operator()(EPI_ARGS) const {
        bf16* base = O + u.z * zstride + u.pn * 256 + wc * 32 + fq * 8; const int row0 = u.pm * 256 + wr * 64 + fr;
        ROWS_LOOP { bf16* rp = base + (size_t)(row0 + ai * 128 + m * 16) * ldo; BJ_LOOP st_bf16x8(rp + bj * 128, acc[ai][bj][m][0], acc[ai][bj][m][1]); }
    }
};
struct EpiPart {
    bf16* P;
    __device__ __forceinline__ void operator()(EPI_ARGS) const {
        bf16* base = P + (size_t)u.z * 65536 + wc * 32 + fq * 8; const int row0 = wr * 64 + fr;
        ROWS_LOOP { bf16* rp = base + (row0 + ai * 128 + m * 16) * 256; BJ_LOOP st_bf16x8(rp + bj * 128, acc[ai][bj][m][0], acc[ai][bj][m][1]); }
    }
};
template <class TB, class TO>
struct EpiResT {
    const TB* base; TO* out; const float* gt;
    __device__ __forceinline__ void operator()(EPI_ARGS) const {
        const int row0 = u.pm * 256 + wr * 64 + fr, col0 = u.pn * 256 + wc * 32 + fq * 8; const float* gtb = gt + (size_t)(u.pm >> 4) * MODW + col0;
        f32x4 gv[2][2];
        COLS_LOOP gv[bj][n] = *(const f32x4*)(gtb + bj * 128 + n * 4) + 1.0f;
        ROWS_LOOP { const size_t off = (size_t)(row0 + ai * 128 + m * 16) * D + col0;
            BJ_LOOP { f32x4 o[2];
#pragma unroll
                for (int n = 0; n < 2; ++n) o[n] = ld4any<TB>(base + off + bj * 128 + n * 4, 0) + gv[bj][n] * acc[ai][bj][m][n];
                if constexpr (sizeof(TO) == 2) st_bf16x8((bf16*)(out + off + bj * 128), o[0], o[1]); else { *(f32x4*)(out + off + bj * 128) = o[0]; *(f32x4*)(out + off + bj * 128 + 4) = o[1]; } }
            asm volatile("" ::: "memory"); }
    }
};
typedef EpiResT<float, float> EpiRes;
struct EpiGU {
    bf16* ACT;
    __device__ __forceinline__ void operator()(EPI_ARGS) const {
        const int row0 = u.pm * 256 + wr * 64 + fr; bf16* base = ACT + u.pn * 128 + wc * 32 + fq * 8;
        ROWS_LOOP { f32x4 v[2];
#pragma unroll
            for (int n = 0; n < 2; ++n) { const f32x4 gq = acc[ai][0][m][n], uq = acc[ai][1][m][n]; v[n][0] = siluf_(gq[0]) * uq[0]; v[n][1] = siluf_(gq[1]) * uq[1]; v[n][2] = siluf_(gq[2]) * uq[2]; v[n][3] = siluf_(gq[3]) * uq[3]; }
            st_bf16x8(base + (size_t)(row0 + ai * 128 + m * 16) * FF, v[0], v[1]); }
    }
};
struct EpiGUi8 {
    bf16* ACT; const float* SA; const unsigned* amax;
    __device__ __forceinline__ void operator()(EPI_ARGS) const {
        const int row0 = u.pm * 256 + wr * 64 + fr; bf16* base = ACT + u.pn * 128 + wc * 32 + fq * 8; const float sw = __uint_as_float(*amax) * (1.0f / 127.0f);
        ROWS_LOOP { const int row = row0 + ai * 128 + m * 16; const float sc = SA[row] * sw; f32x4 v[2];
#pragma unroll
            for (int n = 0; n < 2; ++n) { const i32x4v gi = __builtin_bit_cast(i32x4v, acc[ai][0][m][n]), ui = __builtin_bit_cast(i32x4v, acc[ai][1][m][n]);
                const f32x4 gf = (f32x4){(float)gi[0], (float)gi[1], (float)gi[2], (float)gi[3]} * sc, uf = (f32x4){(float)ui[0], (float)ui[1], (float)ui[2], (float)ui[3]} * sc; v[n] = silu_mul4(gf, uf); }
            { u32x4 w_; w_.x = cvt_pk_bf16(v[0][0], v[0][1]); w_.y = cvt_pk_bf16(v[0][2], v[0][3]); w_.z = cvt_pk_bf16(v[1][0], v[1][1]); w_.w = cvt_pk_bf16(v[1][2], v[1][3]); __builtin_nontemporal_store(w_, (u32x4*)(base + (size_t)row * FF)); } }
    }
};
#ifndef GU8_NT
#define GU8_NT 0
#endif
#if GU8_NT
#define GU8_STORE(v, p) __builtin_nontemporal_store(v, p)
#else
#define GU8_STORE(v, p) (*(p) = (v))
#endif
struct EpiGU8 {
    unsigned char* ACT;
    __device__ __forceinline__ void operator()(EPI_ARGS) const {
        const int row0 = u.pm * 256 + wr * 64 + fr; unsigned char* base = ACT + u.pn * 128 + wc * 32 + (fq & ~1) * 8;
#pragma unroll
        for (int ai = 0; ai < 2; ++ai)
#pragma unroll
            for (int mp = 0; mp < 2; ++mp) { u32x2 w[2];
#pragma unroll
                for (int q = 0; q < 2; ++q) { const int m = 2 * mp + q;
                    { const f32x4 v = silu_mul4(acc[ai][0][m][0], acc[ai][1][m][0]); w[q].x = pk_fp8x4(v[0], v[1], v[2], v[3]); }
                    { const f32x4 v = silu_mul4(acc[ai][0][m][1], acc[ai][1][m][1]); w[q].y = pk_fp8x4(v[0], v[1], v[2], v[3]); } }
                { const auto r = __builtin_amdgcn_permlane16_swap(w[0].x, w[1].x, false, false); w[0].x = r[0]; w[1].x = r[1]; }
                { const auto r = __builtin_amdgcn_permlane16_swap(w[0].y, w[1].y, false, false); w[0].y = r[0]; w[1].y = r[1]; }
                const u32x4 ov = {w[0].x, w[0].y, w[1].x, w[1].y}; u32x4* op = (u32x4*)(base + (size_t)(row0 + ai * 128 + (2 * mp + (fq & 1)) * 16) * FF); GU8_STORE(ov, op); }
    }
};
struct EpiWin {
    bf16* XB; bf16* GATE;
    __device__ __forceinline__ void operator()(EPI_ARGS) const {
        const int row0 = u.pm * 256 + wr * 64 + fr; const bool isg = u.pn >= 4; const int kind = isg ? 3 : 0; bf16* base = (isg ? GATE : XB) + (u.pn & 3) * 256 + wc * 32 + fq * 8;
        ROWS_LOOP { bf16* rp = base + (size_t)(row0 + ai * 128 + m * 16) * D; BJ_LOOP st_bf16x8(rp + bj * 128, act4(acc[ai][bj][m][0], kind), act4(acc[ai][bj][m][1], kind)); }
    }
};
struct EpiGates {
    const float* bg; const float* lam; const bf16* XBC; bf16* AT; bf16* BT;
    __device__ __forceinline__ void operator()(EPI_ARGS) const {
        const int row0 = u.pm * 256 + wr * 64 + fr, j0 = wc * 32 + fq * 8, ch0 = 256 * u.z + 128 * u.pn + j0;
        f32x4 br[2], bi[2], sp[2];
#pragma unroll
        for (int n = 0; n < 2; ++n) { br[n] = *(const f32x4*)(bg + u.z * 512 + 128 * u.pn + j0 + n * 4); bi[n] = *(const f32x4*)(bg + u.z * 512 + 256 + 128 * u.pn + j0 + n * 4);
            const f32x4 l = *(const f32x4*)(lam + ch0 + n * 4); sp[n][0] = -8.0f * softplusf_(-l[0]); sp[n][1] = -8.0f * softplusf_(-l[1]); sp[n][2] = -8.0f * softplusf_(-l[2]); sp[n][3] = -8.0f * softplusf_(-l[3]); }
        ROWS_LOOP { const size_t off = (size_t)(row0 + ai * 128 + m * 16) * D + ch0; const u32x4 xw = *(const u32x4*)(XBC + off); float xv[8]; unpack8(xw, xv);
            f32x4 av[2], bv[2];
#pragma unroll
            for (int n = 0; n < 2; ++n) { const f32x4 rq = acc[ai][0][m][n] + br[n], iq = acc[ai][1][m][n] + bi[n];
#pragma unroll
                for (int h = 0; h < 2; ++h) { const f32x2p rr = sigmoid2(h ? P2HI(rq) : P2LO(rq)), ig = sigmoid2(h ? P2HI(iq) : P2LO(iq)), sp2 = h ? P2HI(sp[n]) : P2LO(sp[n]), xx = (f32x2p){xv[4 * n + 2 * h], xv[4 * n + 2 * h + 1]};
                    const f32x2p la = rr * sp2; const f32x2p om = exp2_2(la * (2.0f * 1.4426950408889634f)) * -1.0f + 1.0f; const f32x2p gx = ig * xx;
                    av[n][2 * h] = la.x; av[n][2 * h + 1] = la.y; bv[n][2 * h] = __builtin_amdgcn_sqrtf(fmaxf(om.x, 0.f)) * gx.x; bv[n][2 * h + 1] = __builtin_amdgcn_sqrtf(fmaxf(om.y, 0.f)) * gx.y; } }
            st_bf16x8(AT + off, av[0], av[1]); st_bf16x8(BT + off, bv[0], bv[1]); }
    }
};
#define XB_TMO      128
#define XB_XCNT(j)  (256  + 64 * (j))
#define XB_XSUB(j)  (1280 + 64 * (j))
#define XB_XGEN(j)  (2304 + 64 * (j))
#define XB_TOP      3328
#define XB_TOPGEN   3392
#define XCD_BAR_WORDS 3456
#define XB_SPIN_CAP (1u << 18)
__device__ __forceinline__ unsigned xb_ld(unsigned* p)              { return __hip_atomic_load(p, __ATOMIC_RELAXED, __HIP_MEMORY_SCOPE_AGENT); }
__device__ __forceinline__ unsigned xb_add(unsigned* p, unsigned v) { return __hip_atomic_fetch_add(p, v, __ATOMIC_RELAXED, __HIP_MEMORY_SCOPE_AGENT); }
__device__ __forceinline__ unsigned xb_xcc_id() { return (unsigned)__builtin_amdgcn_s_getreg((3 << 11) | 20) & 0xFu; }
#define XB_SPIN(cond, bar) do { unsigned _sp = 0; while (cond) { __builtin_amdgcn_s_sleep(1); \
    if ((++_sp & 255u) == 0u) { if (xb_ld(&(bar)[XB_TMO])) break; if (_sp > XB_SPIN_CAP) { atomicAdd(&(bar)[XB_TMO], 1u); break; } } } } while (0)
struct XcdBarrier { unsigned* bar; unsigned x; volatile LAS unsigned* st; };
__device__ __forceinline__ XcdBarrier xcd_barrier_post(unsigned* bar, volatile LAS unsigned* st) {
    XcdBarrier b; b.bar = bar; b.x = xb_xcc_id(); b.st = st;
    if (threadIdx.x == 0) (void)xb_add(&bar[XB_XCNT(b.x)], 1u);
    return b;
}
__device__ __forceinline__ void xcd_barrier_complete(unsigned* bar, unsigned x, unsigned& nloc, unsigned& nx) {
    const unsigned G = gridDim.x * gridDim.y * gridDim.z;
    unsigned sum, cnt, mine, sp = 0u;
    for (;;) {
        sum = 0u; cnt = 0u; mine = 0u;
#pragma unroll
        for (unsigned j = 0; j < 16; ++j) { const unsigned c = xb_ld(&bar[XB_XCNT(j)]); sum += c; cnt += (c > 0u) ? 1u : 0u; mine = (j == x) ? c : mine; }
        if (sum == G) break;
        __builtin_amdgcn_s_sleep(1);
        if ((++sp & 255u) == 0u) { if (xb_ld(&bar[XB_TMO])) break; if (sp > XB_SPIN_CAP) { atomicAdd(&bar[XB_TMO], 1u); break; } }
    }
    nloc = mine > 0u ? mine : 1u; nx = cnt > 0u ? cnt : 1u;
}
__device__ __forceinline__ void xcd_barrier(const XcdBarrier& b) {
    asm volatile("s_waitcnt vmcnt(0)" ::: "memory");
    __syncthreads();
    if (threadIdx.x == 0) {
        unsigned* bar = b.bar;
        __builtin_amdgcn_s_waitcnt(0);
        unsigned nloc = b.st[0], nx = b.st[1];
        if (nloc == 0u) { xcd_barrier_complete(bar, b.x, nloc, nx); b.st[0] = nloc; b.st[1] = nx; }
        const unsigned old = xb_add(&bar[XB_XSUB(b.x)], 1u);
        const unsigned gen = old / nloc;
        if (old + 1u == (gen + 1u) * nloc) {
            __builtin_amdgcn_fence(__ATOMIC_RELEASE, "agent");
            asm volatile("s_waitcnt vmcnt(0)" ::: "memory");
            const unsigned og = xb_add(&bar[XB_TOP], 1u);
            const unsigned tg = og / nx;
            if (og + 1u == (tg + 1u) * nx) xb_add(&bar[XB_TOPGEN], 1u);
            else XB_SPIN(xb_ld(&bar[XB_TOPGEN]) == tg, bar);
            __builtin_amdgcn_fence(__ATOMIC_ACQUIRE, "agent");
            xb_add(&bar[XB_XGEN(b.x)], 1u);
            asm volatile("s_waitcnt vmcnt(0)" ::: "memory");
        } else {
            XB_SPIN(xb_ld(&bar[XB_XGEN(b.x)]) == gen, bar);
            __builtin_amdgcn_fence(__ATOMIC_ACQUIRE, "agent");
            asm volatile("s_waitcnt vmcnt(0)" ::: "memory");
        }
    }
    __syncthreads();
}
struct Frame { LAS unsigned char* lds; int tid, lane, wave, G, bid; };
#define WSP(T_, off) ((T_*)(a.ws + (off)))

struct Mat { const float* W; int ldw, Ks, Ns; bf16* WT; int Kd, Nd, mode, half, f8; const unsigned* amax; };
constexpr int CONV_SCR = 16896;
__device__ __forceinline__ void conv_item(const Mat& mt, int item, LAS float* scr, int lane) {
    const int nblk = mt.Nd / 64, kb = item / nblk, nb = item % nblk, k0 = 64 * kb, n0 = 64 * nb;
    const int kq = lane >> 4, c4 = (lane & 15) * 4, n = n0 + c4; const bool nok = n < mt.Ns;
    f32x4 v[16];
#pragma unroll
    for (int j = 0; j < 16; ++j) { const int k = k0 + 4 * j + kq; v[j] = (f32x4){0.f, 0.f, 0.f, 0.f}; if (nok && k < mt.Ks) v[j] = __builtin_nontemporal_load((const f32x4*)(mt.W + (size_t)k * mt.ldw + n)); }
#pragma unroll
    for (int j = 0; j < 16; ++j) { LAS float* d = scr + (4 * j + kq) * 65 + c4; d[0] = v[j][0]; d[1] = v[j][1]; d[2] = v[j][2]; d[3] = v[j][3]; }
    asm volatile("s_waitcnt lgkmcnt(0)" ::: "memory");
    int r0 = n0;
    if (mt.mode == 1) r0 = (n0 < mt.half) ? ((n0 / 128) * 256 + (n0 % 128)) : (((n0 - mt.half) / 128) * 256 + 128 + ((n0 - mt.half) % 128));
    const int nl = lane >> 3, kc = lane & 7;
#pragma unroll
    for (int q = 0; q < 8; ++q) { const int nc = 8 * q + nl, nn = (nc & 32) + slot32(nc & 31); const LAS float* sp = scr + (8 * kc) * 65 + nc;
        if (mt.f8 == 2) { const float sc = 127.0f / fmaxf(__uint_as_float(*mt.amax), 1e-30f); unsigned b[8];
#pragma unroll
            for (int e = 0; e < 8; ++e) { const int qi = (int)__builtin_rintf(fminf(fmaxf(sp[e * 65] * sc, -127.f), 127.f)); b[e] = (unsigned)qi & 0xffu; }
            u32x2 o8; o8.x = b[0] | (b[1] << 8) | (b[2] << 16) | (b[3] << 24); o8.y = b[4] | (b[5] << 8) | (b[6] << 16) | (b[7] << 24);
            *(u32x2*)((unsigned char*)mt.WT + (size_t)(r0 + nn) * mt.Kd + k0 + 8 * kc) = o8; continue; }
        if (mt.f8) { u32x2 o8; o8.x = pk_fp8x4(sp[0 * 65] * F8_WSCALE, sp[1 * 65] * F8_WSCALE, sp[2 * 65] * F8_WSCALE, sp[3 * 65] * F8_WSCALE); o8.y = pk_fp8x4(sp[4 * 65] * F8_WSCALE, sp[5 * 65] * F8_WSCALE, sp[6 * 65] * F8_WSCALE, sp[7 * 65] * F8_WSCALE);
            __builtin_nontemporal_store(o8, (u32x2*)((unsigned char*)mt.WT + (size_t)(r0 + nn) * mt.Kd + k0 + 8 * kc)); continue; }
        u32x4 o; o.x = cvt_pk_bf16(sp[0 * 65], sp[1 * 65]); o.y = cvt_pk_bf16(sp[2 * 65], sp[3 * 65]); o.z = cvt_pk_bf16(sp[4 * 65], sp[5 * 65]); o.w = cvt_pk_bf16(sp[6 * 65], sp[7 * 65]);
        *(u32x4*)(mt.WT + (size_t)(r0 + nn) * mt.Kd + k0 + 8 * kc) = o; }
    asm volatile("s_waitcnt lgkmcnt(0)" ::: "memory");
}
constexpr int CI_RKV = 256, CI_L1 = 64, CI_L2 = 64, CI_SQ = 256, CI_GU = 1792, CI_D = 896, CI_WIN = 512, CI_GT = 32;
constexpr int MOE_CONV_ITEMS = 8 * CI_GU + 8 * CI_D;
constexpr int B_CONV_ITEMS = MOE_CONV_ITEMS + (FFN_I8 ? CI_GU : 0);
constexpr int CONV_ITEMS = 3 * CI_RKV + 3 * CI_L1 + 3 * CI_L2 + CI_SQ + CI_GU + CI_D + CI_WIN + 4 * CI_GT + CI_SQ + 8 * CI_GU + 8 * CI_D;
__device__ __forceinline__ void conv_dispatch(const Args& a, int it, LAS float* scr, int lane) {
    Mat mt;
    if (it < 8 * CI_GU) { const int e = it / CI_GU; mt = Mat{a.in[I_MGU] + (size_t)e * D * 2 * FF, 2 * FF, D, 2 * FF, MOE_FP8 ? (bf16*)(a.ws + WS_MGU + (size_t)e * 2 * FF * D) : WSP(bf16, WS_MGU) + (size_t)e * 2 * FF * D, D, 2 * FF, 1, FF, MOE_FP8, nullptr}; conv_item(mt, it - e * CI_GU, scr, lane); return; } it -= 8 * CI_GU;
    if (it < 8 * CI_D) { const int e = it / CI_D; mt = Mat{a.in[I_MD] + (size_t)e * FF * D, D, FF, D, MOE_FP8 ? (bf16*)(a.ws + WS_MD + (size_t)e * D * FF) : WSP(bf16, WS_MD) + (size_t)e * D * FF, FF, D, 0, 0, MOE_FP8, nullptr}; conv_item(mt, it - e * CI_D, scr, lane); return; } it -= 8 * CI_D;
    if (it < CI_GU) { mt = Mat{a.in[I_FGU], 2 * FF, D, 2 * FF, WSP(bf16, WS_WGU), D, 2 * FF, 1, FF, FFN_I8 ? 2 : FFN_FP8, (const unsigned*)(CTLP + 32)}; conv_item(mt, it, scr, lane); return; } it -= CI_GU;
    if (it < CI_D) { mt = Mat{a.in[I_FD], D, FF, D, WSP(bf16, WS_WD), FF, D, 0, 0, FFN_FP8, nullptr}; conv_item(mt, it, scr, lane); return; } it -= CI_D;
    if (it < 3 * CI_RKV) { const int z = it / CI_RKV; mt = Mat{a.in[I_WRKV] + (size_t)z * D * D, D, D, D, WSP(bf16, WS_WRKV) + (size_t)z * D * D, D, D, 0, 0, 0, nullptr}; conv_item(mt, it - z * CI_RKV, scr, lane); return; } it -= 3 * CI_RKV;
    if (it < 3 * CI_L1) { const int q = it / CI_L1; const int rk = q == 2 ? 160 : 64; mt = Mat{a.in[q == 0 ? I_W1 : (q == 1 ? I_A1 : I_G1)], rk, D, rk, WSP(bf16, WS_L1T) + (size_t)q * 256 * D, D, 256, 0, 0, 0, nullptr}; conv_item(mt, it - q * CI_L1, scr, lane); return; } it -= 3 * CI_L1;
    if (it < 3 * CI_L2) { const int q = it / CI_L2; const int rk = q == 2 ? 160 : 64; mt = Mat{a.in[q == 0 ? I_W2 : (q == 1 ? I_A2 : I_G2)], D, rk, D, WSP(bf16, WS_L2T) + (size_t)q * D * 256, 256, D, 0, 0, 0, nullptr}; conv_item(mt, it - q * CI_L2, scr, lane); return; } it -= 3 * CI_L2;
    if (it < CI_SQ) { mt = Mat{a.in[I_WO], D, D, D, WSP(bf16, WS_WO), D, D, 0, 0, 0, nullptr}; conv_item(mt, it, scr, lane); return; } it -= CI_SQ;
    if (it < CI_WIN) { mt = Mat{a.in[I_WIN], 2 * D, D, 2 * D, WSP(bf16, WS_WIN), D, 2 * D, 0, 0, 0, nullptr}; conv_item(mt, it, scr, lane); return; } it -= CI_WIN;
    if (it < 4 * CI_GT) { const int z = it / CI_GT; mt = Mat{a.in[I_WGATES] + (size_t)z * 256 * 512, 512, 256, 512, WSP(bf16, WS_WG) + (size_t)z * 512 * 256, 256, 512, 1, 256, 0, nullptr}; conv_item(mt, it - z * CI_GT, scr, lane); return; } it -= 4 * CI_GT;
    mt = Mat{a.in[I_WOUT], D, D, D, WSP(bf16, WS_WOUT), D, D, 0, 0, 0, nullptr}; conv_item(mt, it, scr, lane);
}
__device__ __forceinline__ void ph_prologue(const Args& a, const Frame& F) {
    LAS float* cond = (LAS float*)F.lds; LAS float* red = cond + 4096;
    for (int g = F.bid; g < 192; g += F.G) {
        for (int i = F.tid; i < 4096; i += NTHR) cond[i] = siluf_(a.in[I_C][i]);
        __syncthreads();
        const int l = g / 96, col0 = (g % 96) * 64, c4 = (F.tid & 15) * 4, kr = F.tid >> 4;
        const float* W = a.in[I_ADAW] + (size_t)l * D * MODW + col0 + c4;
        f32x4 s0 = {0.f, 0.f, 0.f, 0.f}, s1 = s0, s2 = s0, s3 = s0;
#pragma unroll 8
        for (int k = kr; k < D; k += 32) { const f32x4 wv = __builtin_nontemporal_load((const f32x4*)(W + (size_t)k * MODW)); s0 += wv * cond[k]; s1 += wv * cond[1024 + k]; s2 += wv * cond[2048 + k]; s3 += wv * cond[3072 + k]; }
        *(LAS f32x4*)(red + (kr * 4 + 0) * 64 + c4) = s0; *(LAS f32x4*)(red + (kr * 4 + 1) * 64 + c4) = s1; *(LAS f32x4*)(red + (kr * 4 + 2) * 64 + c4) = s2; *(LAS f32x4*)(red + (kr * 4 + 3) * 64 + c4) = s3;
        __syncthreads();
        if (F.tid < 256) { const int b = F.tid >> 6, col = F.tid & 63; float s = 0.f;
#pragma unroll
            for (int q = 0; q < 32; ++q) s += red[(q * 4 + b) * 64 + col];
            WSP(float, WS_MOD)[(size_t)(l * 4 + b) * MODW + col0 + col] = s + a.in[I_ADAB][l * MODW + col0 + col]; }
        __syncthreads();
    }
#if FFN_I8
    { const f32x4* W4 = (const f32x4*)a.in[I_FGU]; float mx = 0.f;
      for (size_t i = (size_t)F.bid * NTHR + F.tid; i < (size_t)D * 2 * FF / 4; i += (size_t)F.G * NTHR) { const f32x4 w4 = W4[i]; mx = fmaxf(mx, fmaxf(fmaxf(fabsf(w4[0]), fabsf(w4[1])), fmaxf(fabsf(w4[2]), fabsf(w4[3])))); }
#pragma unroll
      for (int o = 1; o < 64; o <<= 1) mx = fmaxf(mx, __shfl_xor(mx, o));
      if (F.lane == 0) atomicMax((unsigned*)(CTLP + 32), __float_as_uint(mx)); }
#endif
    LAS float* scr = (LAS float*)(F.lds + F.wave * CONV_SCR);
    const int gw = F.bid * NWAVES + F.wave, NGW = F.G * NWAVES;
    for (int it = B_CONV_ITEMS + gw; it < CONV_ITEMS; it += NGW) conv_dispatch(a, it, scr, F.lane);
}

__device__ __forceinline__ void load_gm_sh(const float* g, const float* sh, const float* sc, int lane, f32x4 (&gm)[4], f32x4 (&shv)[4]) {
#pragma unroll
    for (int j = 0; j < 4; ++j) { const f32x4 gv = ((const f32x4*)g)[lane + 64 * j], sv = ((const f32x4*)sc)[lane + 64 * j]; gm[j] = gv * (sv + 1.0f); shv[j] = ((const f32x4*)sh)[lane + 64 * j]; }
}
template <class TX>
__device__ __forceinline__ void mod_row(const TX* xrow, const f32x4 (&gm)[4], const f32x4 (&shv)[4], int lane, f32x4 (&h)[4]) {
    f32x4 v[4]; float ss = 0.f;
#pragma unroll
    for (int j = 0; j < 4; ++j) { v[j] = ld4any<TX>(xrow, lane + 64 * j); ss += (v[j][0] * v[j][0] + v[j][1] * v[j][1]) + (v[j][2] * v[j][2] + v[j][3] * v[j][3]); }
    ss = wave_sum(ss); const float r = 1.0f / sqrtf(ss * (1.0f / D) + 1e-6f);
#pragma unroll
    for (int j = 0; j < 4; ++j) h[j] = (v[j] * r) * gm[j] + shv[j];
}
__device__ __forceinline__ void store_row_bf16(bf16* orow, const f32x4 (&h)[4], int lane) {
#pragma unroll
    for (int j = 0; j < 4; ++j) st_bf16x4(orow + 4 * lane + 256 * j, h[j]);
}

__device__ __forceinline__ void ph_shift(const Args& a, const Frame& F) {
    const float* x = a.in[I_X]; const float* mod = WSP(float, WS_MOD); bf16* XM = WSP(bf16, A_XM);
    const int gw = F.bid * NWAVES + F.wave, NGW = F.G * NWAVES;
    f32x4 mu[6][4];
#pragma unroll
    for (int p = 0; p < 6; ++p)
#pragma unroll
        for (int j = 0; j < 4; ++j) mu[p][j] = ((const f32x4*)(a.in[I_MU] + p * D))[F.lane + 64 * j];
    for (int rb = gw; rb < M / 8; rb += NGW) {
        const int r0 = rb * 8, b = r0 >> 12; const float* mb = mod + (size_t)(0 * 4 + b) * MODW;
        f32x4 gm[4], shv[4], hp[4], h[4];
        load_gm_sh(a.in[I_NORMG] + 0 * 2 * D + 0 * D, mb + 0, mb + 1024, F.lane, gm, shv);
        if ((r0 & (T - 1)) == 0) {
#pragma unroll
            for (int j = 0; j < 4; ++j) hp[j] = (f32x4){0.f, 0.f, 0.f, 0.f};
        } else mod_row(x + (size_t)(r0 - 1) * D, gm, shv, F.lane, hp);
        for (int r = 0; r < 8; ++r) {
            const int row = r0 + r; mod_row(x + (size_t)row * D, gm, shv, F.lane, h);
#pragma unroll
            for (int p = 0; p < 6; ++p) { f32x4 o[4];
#pragma unroll
                for (int j = 0; j < 4; ++j) o[j] = h[j] + (hp[j] - h[j]) * mu[p][j];
                store_row_bf16(XM + ((size_t)p * M + row) * D, o, F.lane); }
#pragma unroll
            for (int j = 0; j < 4; ++j) hp[j] = h[j];
        }
    }
}
__device__ __forceinline__ void ph_modulate(const Args& a, const Frame& F, int l, int s, int f8out = 0) {
    const xres_t* X = XRES(a); const float* mod = WSP(float, WS_MOD); bf16* H = WSP(bf16, A_H);
    const int gw = F.bid * NWAVES + F.wave, NGW = F.G * NWAVES;
    for (int rb = gw; rb < M / 8; rb += NGW) {
        const int r0 = rb * 8, b = r0 >> 12; const float* mb = mod + (size_t)(l * 4 + b) * MODW + s * 3072;
        f32x4 gm[4], shv[4], h[4];
        load_gm_sh(a.in[I_NORMG] + (l * 2 + s) * D, mb + 0, mb + 1024, F.lane, gm, shv);
#pragma unroll 1
        for (int rh = 0; rh < 8; rh += 4) {
        u32x2 raw[4][4];
#pragma unroll
        for (int r = 0; r < 4; ++r)
#pragma unroll
            for (int j = 0; j < 4; ++j) raw[r][j] = ((const u32x2*)(X + (size_t)(r0 + rh + r) * D))[F.lane + 64 * j];
#pragma unroll
        for (int rr_ = 0; rr_ < 4; ++rr_) { const int r = rh + rr_;
            { f32x4 v[4]; float ss = 0.f;
#pragma unroll
              for (int j = 0; j < 4; ++j) { v[j] = unpk4(raw[rr_][j]); ss += (v[j][0] * v[j][0] + v[j][1] * v[j][1]) + (v[j][2] * v[j][2] + v[j][3] * v[j][3]); }
              ss = wave_sum(ss); const float rs = 1.0f / sqrtf(ss * (1.0f / D) + 1e-6f);
#pragma unroll
              for (int j = 0; j < 4; ++j) h[j] = (v[j] * rs) * gm[j] + shv[j]; }
            if (f8out == 2) { unsigned char* h8 = (unsigned char*)H + (size_t)(r0 + r) * D; float mx = 0.f;
#pragma unroll
                for (int j = 0; j < 4; ++j) mx = fmaxf(mx, fmaxf(fmaxf(fabsf(h[j][0]), fabsf(h[j][1])), fmaxf(fabsf(h[j][2]), fabsf(h[j][3]))));
                mx = wave_max(mx);
                mx = fmaxf(mx, 1e-20f); const float inv = 127.0f / mx;
#pragma unroll
                for (int j = 0; j < 4; ++j) { unsigned b[4];
#pragma unroll
                    for (int e = 0; e < 4; ++e) b[e] = (unsigned)(int)__builtin_rintf(h[j][e] * inv) & 0xffu;
                    *(unsigned*)(h8 + 4 * F.lane + 256 * j) = b[0] | (b[1] << 8) | (b[2] << 16) | (b[3] << 24); }
                if (F.lane == 0) WSP(float, WS_SA)[r0 + r] = mx * (1.0f / 127.0f); }
            else if (f8out) { unsigned char* h8 = (unsigned char*)H + (size_t)(r0 + r) * D;
#pragma unroll
                for (int j = 0; j < 4; ++j) *(unsigned*)(h8 + 4 * F.lane + 256 * j) = pk_fp8x4(h[j][0], h[j][1], h[j][2], h[j][3]); }
            else store_row_bf16(H + (size_t)(r0 + r) * D, h, F.lane); } }
    }
}


constexpr size_t A_QG = WS_ARENA, A_Y0G = WS_ARENA + 32 * MiB, A_GG = WS_ARENA + 64 * MiB, A_CTG = WS_ARENA + 96 * MiB, A_H0G = WS_ARENA + 160 * MiB;
constexpr int WK_TC = 32, WK_SF = 5 * 64 + 16;
__device__ __forceinline__ float dpp_f(float x, const int ctrl_sel) {
    const int xi = __builtin_bit_cast(int, x); int r;
    if (ctrl_sel == 0) r = __builtin_amdgcn_update_dpp(0, xi, 0xB1, 0xF, 0xF, true);
    else if (ctrl_sel == 1) r = __builtin_amdgcn_update_dpp(0, xi, 0x4E, 0xF, 0xF, true);
    else if (ctrl_sel == 2) r = __builtin_amdgcn_update_dpp(0, xi, 0x141, 0xF, 0xF, true);
    else r = __builtin_amdgcn_update_dpp(0, xi, 0x140, 0xF, 0xF, true);
    return __builtin_bit_cast(float, r);
}
__device__ __forceinline__ float red16(float x) { x += dpp_f(x, 0); x += dpp_f(x, 1); x += dpp_f(x, 2); x += dpp_f(x, 3); return x; }
__device__ __forceinline__ void wkv_stage_chunk(const Args& a, LAS float* buf, int lt, int lane, int rowc, int c0, int q, const float (&w0)[4], const float (&a0)[4], const float (&kkw)[4], const float (&kaw)[4]) {
    const bf16* RKV = WSP(bf16, A_RKV); const bf16* L2O = WSP(bf16, A_L2O);
    const int lw = lt >> 6, tsub = lane >> 4, j4 = (lane & 15) * 4;
#pragma unroll
    for (int p = 0; p < 2; ++p) {
        const int tl = p * 16 + lw * 4 + tsub; const size_t off = (size_t)(rowc + tl) * D + c0 + j4;
        const u32x2 rw = *(const u32x2*)(RKV + off), kw = *(const u32x2*)(RKV + (size_t)M * D + off), lww = *(const u32x2*)(L2O + off), law = *(const u32x2*)(L2O + (size_t)M * D + off);
        const float rr[4] = {bf2f(rw.x & 0xffffu), __uint_as_float(rw.x & 0xffff0000u), bf2f(rw.y & 0xffffu), __uint_as_float(rw.y & 0xffff0000u)};
        const float kx[4] = {bf2f(kw.x & 0xffffu), __uint_as_float(kw.x & 0xffff0000u), bf2f(kw.y & 0xffffu), __uint_as_float(kw.y & 0xffff0000u)};
        const float lwv[4] = {bf2f(lww.x & 0xffffu), __uint_as_float(lww.x & 0xffff0000u), bf2f(lww.y & 0xffffu), __uint_as_float(lww.y & 0xffff0000u)};
        const float lav[4] = {bf2f(law.x & 0xffffu), __uint_as_float(law.x & 0xffff0000u), bf2f(law.y & 0xffffu), __uint_as_float(law.y & 0xffff0000u)};
        float dec[4], av[4], kk[4], ss = 0.f;
#pragma unroll
        for (int e = 0; e < 4; ++e) { const float wl = -softplusf_(-(w0[e] + lwv[e])) - 0.5f; dec[e] = __expf(-__expf(wl)); av[e] = sigmoidf_(a0[e] + lav[e]); kk[e] = kx[e] * kkw[e]; ss += kk[e] * kk[e]; }
        ss += __shfl_xor(ss, 1); ss += __shfl_xor(ss, 2); ss += __shfl_xor(ss, 4); ss += __shfl_xor(ss, 8);
        const float inv = 1.0f / fmaxf(sqrtf(ss), 1e-12f);
        f32x4 vr, vw, vk, va, vb;
#pragma unroll
        for (int e = 0; e < 4; ++e) { const float kn = kk[e] * inv; vr[e] = rr[e]; vw[e] = dec[e]; vk[e] = kx[e] * (1.0f + (av[e] - 1.0f) * kaw[e]); va[e] = -kn; vb[e] = kn * av[e]; }
        LAS float* dst = buf + tl * WK_SF + j4;
        *(LAS f32x4*)(dst) = vr; *(LAS f32x4*)(dst + 64) = vw; *(LAS f32x4*)(dst + 128) = vk; *(LAS f32x4*)(dst + 192) = va; *(LAS f32x4*)(dst + 256) = vb;
    }
    { const int tl = lt >> 3, i2 = (lt & 7) * 2; const unsigned vw2 = *(const unsigned*)(RKV + (size_t)2 * M * D + (size_t)(rowc + tl) * D + c0 + 16 * q + i2);
      buf[tl * WK_SF + 320 + i2] = bf2f(vw2 & 0xffffu); buf[tl * WK_SF + 320 + i2 + 1] = __uint_as_float(vw2 & 0xffff0000u); }
}
__device__ __forceinline__ void ph_wkv(const Args& a, const Frame& F) {
    float* Y = WSP(float, A_Y);
    LAS float* bufs = (LAS float*)F.lds;
    for (int task = F.bid; task < NB * NH * 4; task += F.G) {
        const int bh = task >> 2, q = task & 3, b = bh >> 4, hd = bh & 15, c0 = hd * 64, row0 = b * T;
        const bool loader = F.wave >= 4; const int lt = F.tid - 256;
        float w0[4], a0[4], kkw[4], kaw[4];
        { const int j4 = (F.lane & 15) * 4;
#pragma unroll
          for (int e = 0; e < 4; ++e) { w0[e] = a.in[I_W0][c0 + j4 + e]; a0[e] = a.in[I_A0][c0 + j4 + e]; kkw[e] = a.in[I_KK][c0 + j4 + e]; kaw[e] = a.in[I_KA][c0 + j4 + e]; } }
        if (loader) wkv_stage_chunk(a, bufs, lt, F.lane, row0, c0, q, w0, a0, kkw, kaw);
        __syncthreads();
        const int rloc = F.wave * 4 + (F.lane >> 4), k4 = (F.lane & 15) * 4;
        float S0 = 0.f, S1 = 0.f, S2 = 0.f, S3 = 0.f;
        for (int ch = 0; ch < T / WK_TC; ++ch) {
            LAS float* cur = bufs + (ch & 1) * (WK_TC * WK_SF);
            if (loader) { if (ch + 1 < T / WK_TC) wkv_stage_chunk(a, bufs + ((ch + 1) & 1) * (WK_TC * WK_SF), lt, F.lane, row0 + (ch + 1) * WK_TC, c0, q, w0, a0, kkw, kaw); }
            else {
                float* yp = Y + (size_t)(row0 + ch * WK_TC) * D + c0 + 16 * q + rloc;
#if WKV_MODE == 1
                if ((ch & 1) == 0) *(u32x2*)(WSP(bf16, A_H0G) + (size_t)(bh * 64 + (ch >> 1)) * 4096 + (16 * q + rloc) * 64 + k4) = pk4((f32x4){S0, S1, S2, S3});
#endif
#pragma unroll 4
                for (int t = 0; t < WK_TC; ++t) {
                    const LAS float* p = cur + t * WK_SF;
                    const f32x4 rv = *(const LAS f32x4*)(p + k4), wv = *(const LAS f32x4*)(p + 64 + k4), kv = *(const LAS f32x4*)(p + 128 + k4), av = *(const LAS f32x4*)(p + 192 + k4), bv = *(const LAS f32x4*)(p + 256 + k4);
                    const float v = p[320 + rloc];
                    float sa = (S0 * av[0] + S1 * av[1]) + (S2 * av[2] + S3 * av[3]);
                    sa = red16(sa);
                    S0 = S0 * wv[0] + (sa * bv[0] + v * kv[0]); S1 = S1 * wv[1] + (sa * bv[1] + v * kv[1]); S2 = S2 * wv[2] + (sa * bv[2] + v * kv[2]); S3 = S3 * wv[3] + (sa * bv[3] + v * kv[3]);
                    float y = (S0 * rv[0] + S1 * rv[1]) + (S2 * rv[2] + S3 * rv[3]);
                    y = red16(y);
                    if ((F.lane & 15) == 0) yp[(size_t)t * D] = y;
                }
            }
            __syncthreads();
        }
    }
}
__device__ __forceinline__ void ph_lru1(const Args& a, const Frame& F) {
    const bf16* AT = WSP(bf16, A_AT); const bf16* BT = WSP(bf16, A_BT); float* CAR = WSP(float, A_CAR);
    for (int it = F.bid; it < NB * 64; it += F.G) {
        const int b = it >> 6, ch = it & 63, c = 2 * F.tid; const size_t off = (size_t)(b * T + ch * 64) * D + c;
        float P0 = 1.f, P1 = 1.f, h0 = 0.f, h1 = 0.f;
#pragma unroll 8
        for (int t = 0; t < 64; ++t) { const unsigned aw = *(const unsigned*)(AT + off + (size_t)t * D), bw = *(const unsigned*)(BT + off + (size_t)t * D);
            const float a0 = __expf(bf2f(aw & 0xffffu)), a1 = __expf(__uint_as_float(aw & 0xffff0000u)); h0 = a0 * h0 + bf2f(bw & 0xffffu); h1 = a1 * h1 + __uint_as_float(bw & 0xffff0000u); P0 *= a0; P1 *= a1; }
        *(f32x2*)(CAR + ((size_t)(b * 64 + ch) * 2 + 0) * D + c) = (f32x2){P0, P1}; *(f32x2*)(CAR + ((size_t)(b * 64 + ch) * 2 + 1) * D + c) = (f32x2){h0, h1};
    }
}
__device__ __forceinline__ void ph_lru2(const Args& a, const Frame& F) {
    const bf16* AT = WSP(bf16, A_AT); const bf16* BT = WSP(bf16, A_BT); const float* CAR = WSP(float, A_CAR); const bf16* GATE = WSP(bf16, A_GATE); bf16* HG = WSP(bf16, A_HG);
    for (int it = F.bid; it < NB * 64; it += F.G) {
        const int b = it >> 6, ch = it & 63, c = 2 * F.tid; const size_t off = (size_t)(b * T + ch * 64) * D + c;
        float h0 = 0.f, h1 = 0.f;
#pragma unroll 1
        for (int j0 = 0; j0 < ch; j0 += 8) { f32x2 P[8], Hl[8];
#pragma unroll
            for (int q = 0; q < 8; ++q) { const int j = (j0 + q < ch) ? j0 + q : ch - 1; P[q] = *(const f32x2*)(CAR + ((size_t)(b * 64 + j) * 2 + 0) * D + c); Hl[q] = *(const f32x2*)(CAR + ((size_t)(b * 64 + j) * 2 + 1) * D + c); }
#pragma unroll
            for (int q = 0; q < 8; ++q) if (j0 + q < ch) { h0 = P[q][0] * h0 + Hl[q][0]; h1 = P[q][1] * h1 + Hl[q][1]; } }
#pragma unroll 1
        for (int tb = 0; tb < 64; tb += 16) { unsigned aw[16], bw[16], gw[16];
#pragma unroll
            for (int t = 0; t < 16; ++t) { aw[t] = *(const unsigned*)(AT + off + (size_t)(tb + t) * D); bw[t] = *(const unsigned*)(BT + off + (size_t)(tb + t) * D); gw[t] = *(const unsigned*)(GATE + off + (size_t)(tb + t) * D); }
#pragma unroll
            for (int t = 0; t < 16; ++t) { h0 = __expf(bf2f(aw[t] & 0xffffu)) * h0 + bf2f(bw[t] & 0xffffu); h1 = __expf(__uint_as_float(aw[t] & 0xffff0000u)) * h1 + __uint_as_float(bw[t] & 0xffff0000u);
                *(unsigned*)(HG + off + (size_t)(tb + t) * D) = cvt_pk_bf16(h0 * bf2f(gw[t] & 0xffffu), h1 * __uint_as_float(gw[t] & 0xffff0000u)); } }
    }
}
constexpr int LDK = 72, MATB = 64 * LDK * 2;
constexpr int LA_AT = 0, LA_BT = MATB, LA_KT = 2 * MATB, LA_UT = 0, LA_RT = 3 * MATB, LA_ATT = 4 * MATB, LA_BHT = 5 * MATB, LA_KHT = 6 * MATB, LA_VT = 7 * MATB;
constexpr int ABS = 68;
constexpr int LA_CUM = 8 * MATB, LA_AAK = LA_CUM + 64 * ABS * 4, LA_MRB = LA_AAK + MATB, LA_MRK = LA_MRB + MATB, LA_AKV = LA_MRK + MATB, LA_PL = LA_AKV + 64 * ABS * 4, LA_SEG = LA_PL + 256, LA_END = LA_SEG + 2048;
constexpr int LA_QS = LA_AAK, LA_CTS = LA_CUM, LA_Y0S = LA_AKV, LA_GS = LA_AKV + 8192;
constexpr int LA_DG = LA_CUM, LA_ABN = LA_CUM + 4096, LA_TI = LA_KT, LA_YT = LA_AAK;
constexpr int LA_BHN = LA_AAK, LA_KHN = LA_MRB, LA_VN = LA_MRK;
static_assert(LA_END <= LDS_BYTES - 1024, "wkv stage A LDS map");
__device__ __forceinline__ f32x4 mma16(const bf16x8 a, const bf16x8 b, const f32x4 c) { return __builtin_amdgcn_mfma_f32_16x16x32_bf16(a, b, c, 0, 0, 0); }
__device__ __forceinline__ bf16x8 ldsfrag(const LAS unsigned char* base, int row, int ks, int fq) { return *(const LAS bf16x8*)(base + (row * LDK + ks * 32 + fq * 8) * 2); }
#define LBAR() do { asm volatile("s_waitcnt lgkmcnt(0)" ::: "memory"); __builtin_amdgcn_s_barrier(); asm volatile("" ::: "memory"); } while (0)

__device__ __forceinline__ void ph_wkv_a(const Args& a, const Frame& F) {
    const bf16* RKV = WSP(bf16, A_RKV); const bf16* L2O = WSP(bf16, A_L2O);
    LAS unsigned char* L = F.lds; LAS float* CUM = (LAS float*)(L + LA_CUM); LAS float* PL = (LAS float*)(L + LA_PL); LAS float* SEG = (LAS float*)(L + LA_SEG);
    const int tid = F.tid, lane = F.lane, w = F.wave, fr = lane & 15, fq = lane >> 4;
    const int NIT = NB * NH * 64, IPW = (NIT + F.G - 1) / F.G;
    const int t = tid >> 3, k0 = (tid & 7) * 8;
    int item = F.bid * IPW; const int item_end = (item + IPW < NIT) ? item + IPW : NIT;
    u32x4 raw[5]; float pw0[8], pa0[8], pkk[8], pka[8], prk[8]; int pbh = -1;
    auto issue = [&](int it) { const int bh = it >> 6, c = it & 63, b = bh >> 4, hd = bh & 15; const size_t off = (size_t)(b * T + c * 64 + t) * D + hd * 64 + k0;
        raw[0] = *(const u32x4*)(RKV + off); raw[1] = *(const u32x4*)(RKV + (size_t)M * D + off); raw[2] = *(const u32x4*)(RKV + (size_t)2 * M * D + off); raw[3] = *(const u32x4*)(L2O + off); raw[4] = *(const u32x4*)(L2O + (size_t)M * D + off); };
    if (item < item_end) issue(item);
    for (; item < item_end; ++item) {
        const int bh = item >> 6, hd = bh & 15, ch0 = hd * 64;
        if (bh != pbh) { pbh = bh;
#pragma unroll
            for (int e = 0; e < 8; ++e) { pw0[e] = a.in[I_W0][ch0 + k0 + e]; pa0[e] = a.in[I_A0][ch0 + k0 + e]; pkk[e] = a.in[I_KK][ch0 + k0 + e]; pka[e] = a.in[I_KA][ch0 + k0 + e]; prk[e] = a.in[I_RK][ch0 + k0 + e]; } }
        f32x2p rr[4], vv[4], ain[4], bin[4], kmod[4];
        { float f0[8], f1[8], f2[8], f3[8], f4[8]; unpack8(raw[0], f0); unpack8(raw[1], f1); unpack8(raw[2], f2); unpack8(raw[3], f3); unpack8(raw[4], f4);
          f32x2p kk[4], av[4], kx[4], ss2 = (f32x2p){0.f, 0.f}; float ld[8];
#pragma unroll
          for (int h = 0; h < 4; ++h) { rr[h] = (f32x2p){f0[2 * h], f0[2 * h + 1]}; kx[h] = (f32x2p){f1[2 * h], f1[2 * h + 1]}; vv[h] = (f32x2p){f2[2 * h], f2[2 * h + 1]};
              const f32x2p lw = (f32x2p){f3[2 * h], f3[2 * h + 1]}, la = (f32x2p){f4[2 * h], f4[2 * h + 1]}, w0 = (f32x2p){pw0[2 * h], pw0[2 * h + 1]}, a0 = (f32x2p){pa0[2 * h], pa0[2 * h + 1]}, ck = (f32x2p){pkk[2 * h], pkk[2 * h + 1]};
              const f32x2p e1 = exp2_2((w0 + lw) * -1.4426950408889634f) + 1.0f; f32x2p l2; l2.x = __builtin_amdgcn_logf(e1.x); l2.y = __builtin_amdgcn_logf(e1.y);
              const f32x2p dl = exp2_2(l2 * -1.0f - 0.72134752044448170f) * -1.4426950408889634f; ld[2 * h] = dl.x; ld[2 * h + 1] = dl.y;
              av[h] = sigmoid2(a0 + la); kk[h] = kx[h] * ck; ss2 = kk[h] * kk[h] + ss2; }
          float ss = ss2.x + ss2.y;
          ss += __shfl_xor(ss, 1); ss += __shfl_xor(ss, 2); ss += __shfl_xor(ss, 4);
          const float inv = __builtin_amdgcn_rsqf(fmaxf(ss, 1e-24f)); f32x2p bs2 = (f32x2p){0.f, 0.f};
#pragma unroll
          for (int h = 0; h < 4; ++h) { const f32x2p kn = kk[h] * inv, ka = (f32x2p){pka[2 * h], pka[2 * h + 1]}, rk = (f32x2p){prk[2 * h], prk[2 * h + 1]}; ain[h] = kn * -1.0f; bin[h] = kn * av[h]; kmod[h] = kx[h] * ((av[h] - 1.0f) * ka + 1.0f);
              bs2 = rr[h] * kmod[h] * rk + bs2; }
          { float bsum = bs2.x + bs2.y;
            bsum += __shfl_xor(bsum, 1); bsum += __shfl_xor(bsum, 2); bsum += __shfl_xor(bsum, 4);
            if ((tid & 7) == 0) WSP(float, A_Y)[(size_t)item * 64 + t] = bsum; }
          *(LAS f32x4*)(CUM + t * 64 + k0) = (f32x4){ld[0], ld[1], ld[2], ld[3]}; *(LAS f32x4*)(CUM + t * 64 + k0 + 4) = (f32x4){ld[4], ld[5], ld[6], ld[7]}; }
        if (item + 1 < item_end) issue(item + 1);
        LBAR();
        { const int kq = tid & 63, sg = tid >> 6; float run = 0.f;
#pragma unroll
          for (int e = 0; e < 8; ++e) { run += CUM[(8 * sg + e) * 64 + kq]; CUM[(8 * sg + e) * 64 + kq] = run; }
          SEG[sg * 64 + kq] = run;
          LBAR();
          float offs = 0.f;
#pragma unroll
          for (int q = 0; q < 7; ++q) offs += (q < sg) ? SEG[q * 64 + kq] : 0.f;
#pragma unroll
          for (int e = 0; e < 8; ++e) CUM[(8 * sg + e) * 64 + kq] += offs; }
        LBAR();
        { f32x2p o1[4], o2[4], o3[4], o4[4], o5[4], o6[4];
#pragma unroll
          for (int q = 0; q < 2; ++q) { const f32x4 ct4 = *(const LAS f32x4*)(CUM + t * 64 + k0 + 4 * q), cl4 = *(const LAS f32x4*)(CUM + 63 * 64 + k0 + 4 * q); f32x4 cm4 = (f32x4){0.f, 0.f, 0.f, 0.f}; if (t > 0) cm4 = *(const LAS f32x4*)(CUM + (t - 1) * 64 + k0 + 4 * q);
#pragma unroll
              for (int hh = 0; hh < 2; ++hh) { const int h = 2 * q + hh; const f32x2p ct = hh ? P2HI(ct4) : P2LO(ct4), cm = hh ? P2HI(cm4) : P2LO(cm4), cl = hh ? P2HI(cl4) : P2LO(cl4);
                  const f32x2p p = exp2_2(ct), pm1 = exp2_2(cm), ip = exp2_2(ct * -1.0f), pr = exp2_2(cl - ct);
                  o1[h] = ain[h] * pm1; o2[h] = bin[h] * ip; o3[h] = kmod[h] * ip; o4[h] = rr[h] * p; o5[h] = bin[h] * pr; o6[h] = kmod[h] * pr;
                  if (t == 63) { PL[k0 + 2 * h] = p.x; PL[k0 + 2 * h + 1] = p.y; } } }
          const int no = (t * LDK + k0) * 2; u32x4 q;
          q.x = cvt_pk_bf16(o1[0].x, o1[0].y); q.y = cvt_pk_bf16(o1[1].x, o1[1].y); q.z = cvt_pk_bf16(o1[2].x, o1[2].y); q.w = cvt_pk_bf16(o1[3].x, o1[3].y); *(LAS u32x4*)(L + LA_AT + no) = q;
          q.x = cvt_pk_bf16(o2[0].x, o2[0].y); q.y = cvt_pk_bf16(o2[1].x, o2[1].y); q.z = cvt_pk_bf16(o2[2].x, o2[2].y); q.w = cvt_pk_bf16(o2[3].x, o2[3].y); *(LAS u32x4*)(L + LA_BT + no) = q;
          q.x = cvt_pk_bf16(o3[0].x, o3[0].y); q.y = cvt_pk_bf16(o3[1].x, o3[1].y); q.z = cvt_pk_bf16(o3[2].x, o3[2].y); q.w = cvt_pk_bf16(o3[3].x, o3[3].y); *(LAS u32x4*)(L + LA_KT + no) = q;
          q.x = cvt_pk_bf16(o4[0].x, o4[0].y); q.y = cvt_pk_bf16(o4[1].x, o4[1].y); q.z = cvt_pk_bf16(o4[2].x, o4[2].y); q.w = cvt_pk_bf16(o4[3].x, o4[3].y); *(LAS u32x4*)(L + LA_RT + no) = q;
          q.x = cvt_pk_bf16(o5[0].x, o5[0].y); q.y = cvt_pk_bf16(o5[1].x, o5[1].y); q.z = cvt_pk_bf16(o5[2].x, o5[2].y); q.w = cvt_pk_bf16(o5[3].x, o5[3].y); *(LAS u32x4*)(L + LA_BHN + no) = q;
          q.x = cvt_pk_bf16(o6[0].x, o6[0].y); q.y = cvt_pk_bf16(o6[1].x, o6[1].y); q.z = cvt_pk_bf16(o6[2].x, o6[2].y); q.w = cvt_pk_bf16(o6[3].x, o6[3].y); *(LAS u32x4*)(L + LA_KHN + no) = q;
          q.x = cvt_pk_bf16(vv[0].x, vv[0].y); q.y = cvt_pk_bf16(vv[1].x, vv[1].y); q.z = cvt_pk_bf16(vv[2].x, vv[2].y); q.w = cvt_pk_bf16(vv[3].x, vv[3].y); *(LAS u32x4*)(L + LA_VN + no) = q; }
        LBAR();
        { const int kq = tid & 63, tb = tid >> 6;
#pragma unroll
          for (int mi = 0; mi < 4; ++mi) { const int so = (mi == 0) ? LA_AT : ((mi == 1) ? LA_BHN : ((mi == 2) ? LA_KHN : LA_VN)), dofs = (mi == 0) ? LA_ATT : ((mi == 1) ? LA_BHT : ((mi == 2) ? LA_KHT : LA_VT));
              unsigned h[8];
#pragma unroll
              for (int e = 0; e < 8; ++e) h[e] = *(const LAS bf16*)(L + so + ((8 * tb + e) * LDK + kq) * 2);
              u32x4 q; q.x = h[0] | (h[1] << 16); q.y = h[2] | (h[3] << 16); q.z = h[4] | (h[5] << 16); q.w = h[6] | (h[7] << 16);
              *(LAS u32x4*)(L + dofs + (kq * LDK + 8 * tb) * 2) = q; } }
        LBAR();
        { const int prod = w & 3, th = w >> 2; const LAS unsigned char* aM = L + ((prod & 1) ? LA_KT : LA_BT); const LAS unsigned char* bM = L + ((prod < 2) ? LA_AT : LA_RT);
#pragma unroll
          for (int tt = 0; tt < 2; ++tt) { const int tti = (th == 0) ? 3 * tt : 1 + tt, t0 = tti * 16; const bf16x8 b0 = ldsfrag(bM, t0 + fr, 0, fq), b1 = ldsfrag(bM, t0 + fr, 1, fq);
#pragma unroll
              for (int st = 0; st < 4; ++st) { const int s0 = st * 16; f32x4 z = (f32x4){0.f, 0.f, 0.f, 0.f};
                  if (st <= tti) { z = mma16(ldsfrag(aM, s0 + fr, 0, fq), b0, z); z = mma16(ldsfrag(aM, s0 + fr, 1, fq), b1, z); }
                  const int tq = t0 + fr, sb = s0 + 4 * fq;
                  if (st == tti) {
#pragma unroll
                      for (int r = 0; r < 4; ++r) { const bool keep = (prod < 2) ? (sb + r < tq) : (sb + r <= tq); z[r] = keep ? z[r] : 0.f; } }
                  if (prod == 0) {
                      if (st == tti) { *(LAS f32x4*)(L + LA_DG + ((tti * 16 + fr) * 16 + 4 * fq) * 4) = z; z = (f32x4){0.f, 0.f, 0.f, 0.f}; }
                      *(LAS u32x2*)(L + LA_ABN + (tq * LDK + sb) * 2) = pk4(z); }
                  else { const int mo = (prod == 1) ? LA_AAK : ((prod == 2) ? LA_MRB : LA_MRK); *(LAS u32x2*)(L + mo + (tq * LDK + sb) * 2) = pk4(z); } } } }
        LBAR();
        if (w == 0) {
          const int tb = lane >> 4, tc = lane & 15; float Tc[16];
#pragma unroll
          for (int r = 0; r < 16; ++r) { float av[16];
#pragma unroll
              for (int q = 0; q < (r + 3) / 4; ++q) { const f32x4 t4 = *(const LAS f32x4*)(L + LA_DG + ((tb * 16 + r) * 16 + 4 * q) * 4); av[4 * q] = t4[0]; av[4 * q + 1] = t4[1]; av[4 * q + 2] = t4[2]; av[4 * q + 3] = t4[3]; }
              float s0 = (r == tc) ? 1.f : 0.f, s1 = 0.f;
#pragma unroll
              for (int j = 0; j < r; ++j) { if (j & 1) s1 += av[j] * Tc[j]; else s0 += av[j] * Tc[j]; }
              Tc[r] = s0 + s1; }
#pragma unroll
          for (int r = 0; r < 16; ++r) *(LAS bf16*)(L + LA_TI + ((tb * 16 + r) * 32 + tc) * 2) = (bf16)(cvt_pk_bf16(Tc[r], 0.f) & 0xffffu);
        } else {
#pragma unroll 1
          for (int q = w - 1; q < 16; q += 7) { const int v0 = (q >> 2) * 16, t0 = (q & 3) * 16; f32x4 z = (f32x4){0.f, 0.f, 0.f, 0.f};
              z = mma16(ldsfrag(L + LA_AAK, t0 + fr, 0, fq), ldsfrag(L + LA_VT, v0 + fr, 0, fq), z); z = mma16(ldsfrag(L + LA_AAK, t0 + fr, 1, fq), ldsfrag(L + LA_VT, v0 + fr, 1, fq), z);
              *(LAS f32x4*)(L + LA_AKV + ((v0 + fr) * ABS + t0 + 4 * fq) * 4) = z; }
        }
        LBAR();
        { const int col = 16 * w + fr; u32x2 ub[4];
#pragma unroll
          for (int i = 0; i < 4; ++i) ub[i] = (u32x2){0u, 0u};
#pragma unroll
          for (int i = 0; i < 4; ++i) {
              f32x4 y;
              if (w < 4) y = unpk4(*(const LAS u32x2*)(L + LA_ATT + (col * LDK + 16 * i + 4 * fq) * 2)); else y = *(const LAS f32x4*)(L + LA_AKV + ((col - 64) * ABS + 16 * i + 4 * fq) * 4);
#pragma unroll
              for (int ks = 0; ks < (i + 1) / 2; ++ks) { const int j0 = 2 * ks;
                  const u32x2 alo = *(const LAS u32x2*)(L + LA_ABN + ((16 * i + fr) * LDK + 16 * j0 + 4 * fq) * 2), ahi = *(const LAS u32x2*)(L + LA_ABN + ((16 * i + fr) * LDK + 16 * (j0 + 1) + 4 * fq) * 2);
                  y = mma16(__builtin_bit_cast(bf16x8, (u32x4){alo.x, alo.y, ahi.x, ahi.y}), __builtin_bit_cast(bf16x8, (u32x4){ub[j0].x, ub[j0].y, ub[j0 + 1].x, ub[j0 + 1].y}), y); }
              const u32x2 yp = pk4(y), tlo = *(const LAS u32x2*)(L + LA_TI + ((i * 16 + fr) * 32 + 4 * fq) * 2);
              const f32x4 uo = mma16(__builtin_bit_cast(bf16x8, (u32x4){tlo.x, tlo.y, 0u, 0u}), __builtin_bit_cast(bf16x8, (u32x4){yp.x, yp.y, 0u, 0u}), (f32x4){0.f, 0.f, 0.f, 0.f});
              ub[i] = pk4(uo);
              *(LAS u32x2*)(L + LA_UT + (col * LDK + 16 * i + 4 * fq) * 2) = ub[i];
          } }
        LBAR();
        { const size_t ib = (size_t)item * 4096;
#pragma unroll
          for (int jj = 0; jj < 2; ++jj) { const int j0 = (w >> 1) * 16, kind = 2 * (w & 1) + jj;
#pragma unroll
              for (int it = 0; it < 4; ++it) { const int i0 = it * 16; f32x4 z = (f32x4){0.f, 0.f, 0.f, 0.f};
                  if (kind == 0) {
                      z = mma16(ldsfrag(L + LA_UT, i0 + fr, 0, fq), ldsfrag(L + LA_MRB, j0 + fr, 0, fq), z); z = mma16(ldsfrag(L + LA_UT, i0 + fr, 1, fq), ldsfrag(L + LA_MRB, j0 + fr, 1, fq), z);
                      z += unpk4(*(const LAS u32x2*)(L + LA_RT + ((j0 + fr) * LDK + i0 + 4 * fq) * 2));
                      *(u32x2*)(WSP(bf16, A_QG) + ib + (j0 + fr) * 64 + i0 + 4 * fq) = pk4(z);
                  } else if (kind == 1) {
                      z = mma16(ldsfrag(L + LA_UT, 64 + i0 + fr, 0, fq), ldsfrag(L + LA_MRB, j0 + fr, 0, fq), z); z = mma16(ldsfrag(L + LA_UT, 64 + i0 + fr, 1, fq), ldsfrag(L + LA_MRB, j0 + fr, 1, fq), z);
                      z = mma16(ldsfrag(L + LA_VT, i0 + fr, 0, fq), ldsfrag(L + LA_MRK, j0 + fr, 0, fq), z); z = mma16(ldsfrag(L + LA_VT, i0 + fr, 1, fq), ldsfrag(L + LA_MRK, j0 + fr, 1, fq), z);
                      *(u32x2*)(WSP(bf16, A_Y0G) + ib + (j0 + fr) * 64 + i0 + 4 * fq) = pk4(z);
                  } else if (kind == 2) {
                      z = mma16(ldsfrag(L + LA_UT, i0 + fr, 0, fq), ldsfrag(L + LA_BHT, j0 + fr, 0, fq), z); z = mma16(ldsfrag(L + LA_UT, i0 + fr, 1, fq), ldsfrag(L + LA_BHT, j0 + fr, 1, fq), z);
                      const float pl = PL[j0 + fr];
#pragma unroll
                      for (int r = 0; r < 4; ++r) z[r] += (i0 + 4 * fq + r == j0 + fr) ? pl : 0.f;
                      *(u32x2*)(WSP(bf16, A_GG) + ib + (j0 + fr) * 64 + i0 + 4 * fq) = pk4(z);
                  } else {
                      z = mma16(ldsfrag(L + LA_BHT, i0 + fr, 0, fq), ldsfrag(L + LA_UT, 64 + j0 + fr, 0, fq), z); z = mma16(ldsfrag(L + LA_BHT, i0 + fr, 1, fq), ldsfrag(L + LA_UT, 64 + j0 + fr, 1, fq), z);
                      z = mma16(ldsfrag(L + LA_KHT, i0 + fr, 0, fq), ldsfrag(L + LA_VT, j0 + fr, 0, fq), z); z = mma16(ldsfrag(L + LA_KHT, i0 + fr, 1, fq), ldsfrag(L + LA_VT, j0 + fr, 1, fq), z);
                      *(f32x4*)(WSP(float, A_CTG) + ib + (j0 + fr) * 64 + i0 + 4 * fq) = z;
                  } } } }
    }
    __syncthreads();
}
__device__ __forceinline__ void wkv_b_load(const bf16* GG, const float* CTG, int item, int v0, int kb, int fr, int fq, bf16x8 (&ga)[2][2], f32x4 (&ct)[2]) {
    const size_t ib = (size_t)item * 4096;
#pragma unroll
    for (int kk = 0; kk < 2; ++kk) { const int k0 = (kb + kk) * 16; ct[kk] = *(const f32x4*)(CTG + ib + (v0 + fr) * 64 + k0 + 4 * fq);
#pragma unroll
        for (int ks = 0; ks < 2; ++ks) ga[kk][ks] = *(const bf16x8*)(GG + ib + (k0 + fr) * 64 + ks * 32 + fq * 8); }
}
__device__ __forceinline__ void wkv_b_step(LAS unsigned char* L, bf16* H0G, int item, int c, int tid, int v0, int kb, int fr, int fq, const bf16x8 (&ga)[2][2], const f32x4 (&ct)[2]) {
    const LAS unsigned char* cur = L + (c & 1) * MATB; LAS unsigned char* nxt = L + ((c + 1) & 1) * MATB;
    { const int row = tid >> 3, seg = tid & 7; *(u32x4*)(H0G + (size_t)item * 4096 + row * 64 + seg * 8) = *(const LAS u32x4*)(cur + (row * LDK + seg * 8) * 2); }
#pragma unroll
    for (int kk = 0; kk < 2; ++kk) { f32x4 z = ct[kk]; z = mma16(ga[kk][0], ldsfrag(cur, v0 + fr, 0, fq), z); z = mma16(ga[kk][1], ldsfrag(cur, v0 + fr, 1, fq), z);
        *(LAS u32x2*)(nxt + ((v0 + fr) * LDK + (kb + kk) * 16 + 4 * fq) * 2) = pk4(z); }
    LBAR();
}
__device__ __forceinline__ void ph_wkv_b(const Args& a, const Frame& F) {
    LAS unsigned char* L = F.lds; const int tid = F.tid, lane = F.lane, w = F.wave, fr = lane & 15, fq = lane >> 4;
    const bf16* GG = WSP(bf16, A_GG); const float* CTG = WSP(float, A_CTG); bf16* H0G = WSP(bf16, A_H0G);
    for (int bh = F.bid; bh < NB * NH; bh += F.G) {
        for (int i = tid; i < 2 * MATB / 4; i += NTHR) ((LAS unsigned*)L)[i] = 0u;
        const int v0 = (w >> 1) * 16, kb = 2 * (w & 1);
        bf16x8 gaA[2][2], gaB[2][2], gaC[2][2], gaD[2][2]; f32x4 ctA[2], ctB[2], ctC[2], ctD[2];
        wkv_b_load(GG, CTG, bh * 64, v0, kb, fr, fq, gaA, ctA); wkv_b_load(GG, CTG, bh * 64 + 1, v0, kb, fr, fq, gaB, ctB);
        wkv_b_load(GG, CTG, bh * 64 + 2, v0, kb, fr, fq, gaC, ctC); wkv_b_load(GG, CTG, bh * 64 + 3, v0, kb, fr, fq, gaD, ctD);
        LBAR();
        for (int c = 0; c < 64; c += 4) {
            wkv_b_step(L, H0G, bh * 64 + c, c, tid, v0, kb, fr, fq, gaA, ctA);
            wkv_b_load(GG, CTG, bh * 64 + (c + 4 < 64 ? c + 4 : 63), v0, kb, fr, fq, gaA, ctA);
            wkv_b_step(L, H0G, bh * 64 + c + 1, c + 1, tid, v0, kb, fr, fq, gaB, ctB);
            wkv_b_load(GG, CTG, bh * 64 + (c + 5 < 64 ? c + 5 : 63), v0, kb, fr, fq, gaB, ctB);
            wkv_b_step(L, H0G, bh * 64 + c + 2, c + 2, tid, v0, kb, fr, fq, gaC, ctC);
            wkv_b_load(GG, CTG, bh * 64 + (c + 6 < 64 ? c + 6 : 63), v0, kb, fr, fq, gaC, ctC);
            wkv_b_step(L, H0G, bh * 64 + c + 3, c + 3, tid, v0, kb, fr, fq, gaD, ctD);
            wkv_b_load(GG, CTG, bh * 64 + (c + 7 < 64 ? c + 7 : 63), v0, kb, fr, fq, gaD, ctD);
        }
    }
    __syncthreads();
    { const int nchain = NB * NH, idle0 = (F.G > nchain) ? nchain : 0;
      if (F.bid >= idle0) { LAS float* scr = (LAS float*)(F.lds + F.wave * CONV_SCR); const int gw = (F.bid - idle0) * NWAVES + F.wave, NGW = (F.G - idle0) * NWAVES;
          for (int it = gw; it < B_CONV_ITEMS; it += NGW) conv_dispatch(a, it, scr, F.lane); } }
}
__device__ __forceinline__ void ph_wkv_c(const Args& a, const Frame& F) {
    const bf16* RKV = WSP(bf16, A_RKV); const bf16* L2O = WSP(bf16, A_L2O); bf16* YG = WSP(bf16, A_YG);
    const bf16* QG = WSP(bf16, A_QG); const bf16* Y0G = WSP(bf16, A_Y0G); const bf16* H0G = WSP(bf16, A_H0G);
    const int lane = F.lane, fr = lane & 15, fq = lane >> 4; const int gw = F.bid * NWAVES + F.wave, NGW = F.G * NWAVES;
    for (int item = gw; item < NB * NH * 64; item += NGW) {
        const int bh = item >> 6, c = item & 63, b = bh >> 4, hd = bh & 15, ch0 = hd * 64; const size_t ib = (size_t)item * 4096;
        bf16x8 hf[4][2];
#pragma unroll
        for (int vb = 0; vb < 4; ++vb) { const int vr = 32 * (vb >> 1) + 8 * (fr >> 2) + 4 * (vb & 1) + (fr & 3);
            hf[vb][0] = *(const bf16x8*)(H0G + ib + vr * 64 + fq * 8); hf[vb][1] = *(const bf16x8*)(H0G + ib + vr * 64 + 32 + fq * 8); }
        f32x4 gw4[2][2], gb4[2][2];
#pragma unroll
        for (int g = 0; g < 2; ++g)
#pragma unroll
            for (int n = 0; n < 2; ++n) { gw4[g][n] = *(const f32x4*)(a.in[I_GNW] + ch0 + 32 * g + 8 * fq + 4 * n); gb4[g][n] = *(const f32x4*)(a.in[I_GNB] + ch0 + 32 * g + 8 * fq + 4 * n); }
#pragma unroll 1
        for (int tt = 0; tt < 4; ++tt) {
            const int t0 = tt * 16, row = b * T + c * 64 + t0 + fr;
            const bf16x8 q0 = *(const bf16x8*)(QG + ib + (t0 + fr) * 64 + fq * 8), q1 = *(const bf16x8*)(QG + ib + (t0 + fr) * 64 + 32 + fq * 8);
            f32x4 y[2][2];
#pragma unroll
            for (int g = 0; g < 2; ++g) { float y8[8]; unpack8(*(const u32x4*)(Y0G + ib + (t0 + fr) * 64 + 32 * g + 8 * fq), y8);
#pragma unroll
                for (int n = 0; n < 2; ++n) { y[g][n] = (f32x4){y8[4 * n], y8[4 * n + 1], y8[4 * n + 2], y8[4 * n + 3]}; y[g][n] = mma16(hf[2 * g + n][0], q0, y[g][n]); y[g][n] = mma16(hf[2 * g + n][1], q1, y[g][n]); } }
            float s = 0.f;
#pragma unroll
            for (int g = 0; g < 2; ++g)
#pragma unroll
                for (int n = 0; n < 2; ++n) s += (y[g][n][0] + y[g][n][1]) + (y[g][n][2] + y[g][n][3]);
            s += __shfl_xor(s, 16); s += __shfl_xor(s, 32); const float mean = s * (1.0f / 64.0f);
            float q2 = 0.f;
#pragma unroll
            for (int g = 0; g < 2; ++g)
#pragma unroll
                for (int n = 0; n < 2; ++n)
#pragma unroll
                    for (int r = 0; r < 4; ++r) { const float d = y[g][n][r] - mean; q2 += d * d; }
            q2 += __shfl_xor(q2, 16); q2 += __shfl_xor(q2, 32); const float rstd = __builtin_amdgcn_rsqf(q2 * (1.0f / 64.0f) + 64e-5f);
            const float bs = WSP(float, A_Y)[(size_t)item * 64 + t0 + fr];
#pragma unroll
            for (int g = 0; g < 2; ++g) { const size_t oo = (size_t)row * D + ch0 + 32 * g + 8 * fq; float v8[8], g8[8];
                unpack8(*(const u32x4*)(RKV + (size_t)2 * M * D + oo), v8); unpack8(*(const u32x4*)(L2O + (size_t)2 * M * D + oo), g8);
                f32x4 o[2];
#pragma unroll
                for (int n = 0; n < 2; ++n)
#pragma unroll
                    for (int r = 0; r < 4; ++r) o[n][r] = (((y[g][n][r] - mean) * rstd) * gw4[g][n][r] + gb4[g][n][r] + v8[4 * n + r] * bs) * g8[4 * n + r];
                st_bf16x8(YG + oo, o[0], o[1]); }
        }
    }
}
__global__ void __launch_bounds__(64) k_wkv_naive(Args a) {
    __shared__ float sR[64], sW[64], sK[64], sA[64], sB[64];
    const int bh = blockIdx.x, b = bh >> 4, hd = bh & 15, j = threadIdx.x, c = hd * 64 + j;
    const bf16* RKV = WSP(bf16, A_RKV); const bf16* L2O = WSP(bf16, A_L2O); float* Y = WSP(float, A_Y);
    const float w0 = a.in[I_W0][c], a0 = a.in[I_A0][c], kkw = a.in[I_KK][c], kaw = a.in[I_KA][c];
    float S[64];
#pragma unroll
    for (int k = 0; k < 64; ++k) S[k] = 0.f;
    for (int t = 0; t < T; ++t) {
        const size_t off = (size_t)(b * T + t) * D + c;
        const float r = bf2f(RKV[off]), kx = bf2f(RKV[(size_t)M * D + off]), v = bf2f(RKV[(size_t)2 * M * D + off]);
        const float lw = bf2f(L2O[off]), la = bf2f(L2O[(size_t)M * D + off]);
        const float wlog = -softplusf_(-(w0 + lw)) - 0.5f; const float dec = __expf(-__expf(wlog));
        const float av = sigmoidf_(a0 + la);
        float kk = kx * kkw; const float ss = wave_sum(kk * kk); kk = kk / fmaxf(sqrtf(ss), 1e-12f);
        const float kmod = kx * (1.0f + (av - 1.0f) * kaw);
        __syncthreads();
        sR[j] = r; sW[j] = dec; sK[j] = kmod; sA[j] = -kk; sB[j] = kk * av;
        __syncthreads();
        float sa = 0.f;
#pragma unroll
        for (int k = 0; k < 64; ++k) sa += S[k] * sA[k];
        float y = 0.f;
#pragma unroll
        for (int k = 0; k < 64; ++k) { S[k] = S[k] * sW[k] + sa * sB[k] + v * sK[k]; y += S[k] * sR[k]; }
        Y[off] = y;
    }
}
__device__ __forceinline__ void ph_post(const Args& a, const Frame& F) {
    const bf16* RKV = WSP(bf16, A_RKV); const bf16* L2O = WSP(bf16, A_L2O); const float* Y = WSP(float, A_Y); bf16* YG = WSP(bf16, A_YG);
    const int gw = F.bid * NWAVES + F.wave, NGW = F.G * NWAVES, c0 = 16 * F.lane;
    for (int row = gw; row < M; row += NGW) {
        const size_t off = (size_t)row * D + c0;
        float y[16], r[16], k[16], v[16], la[16], gq[16];
#pragma unroll
        for (int q = 0; q < 4; ++q) { const f32x4 t = *(const f32x4*)(Y + off + 4 * q); y[4 * q] = t[0]; y[4 * q + 1] = t[1]; y[4 * q + 2] = t[2]; y[4 * q + 3] = t[3]; }
#pragma unroll
        for (int q = 0; q < 2; ++q) { float f[8];
            unpack8(*(const u32x4*)(RKV + off + 8 * q), f);
#pragma unroll
            for (int e = 0; e < 8; ++e) r[8 * q + e] = f[e];
            unpack8(*(const u32x4*)(RKV + (size_t)M * D + off + 8 * q), f);
#pragma unroll
            for (int e = 0; e < 8; ++e) k[8 * q + e] = f[e];
            unpack8(*(const u32x4*)(RKV + (size_t)2 * M * D + off + 8 * q), f);
#pragma unroll
            for (int e = 0; e < 8; ++e) v[8 * q + e] = f[e];
            unpack8(*(const u32x4*)(L2O + (size_t)M * D + off + 8 * q), f);
#pragma unroll
            for (int e = 0; e < 8; ++e) la[8 * q + e] = f[e];
            unpack8(*(const u32x4*)(L2O + (size_t)2 * M * D + off + 8 * q), f);
#pragma unroll
            for (int e = 0; e < 8; ++e) gq[8 * q + e] = f[e]; }
        float s = 0.f;
#pragma unroll
        for (int e = 0; e < 16; ++e) s += y[e];
        s += __shfl_xor(s, 1); s += __shfl_xor(s, 2); const float mean = s * (1.0f / 64.0f);
        float q2 = 0.f;
#pragma unroll
        for (int e = 0; e < 16; ++e) { const float d = y[e] - mean; q2 += d * d; }
        q2 += __shfl_xor(q2, 1); q2 += __shfl_xor(q2, 2); const float rstd = 1.0f / sqrtf(q2 * (1.0f / 64.0f) + 64e-5f);
        float bs = 0.f;
#pragma unroll
        for (int e = 0; e < 16; ++e) { const float av = sigmoidf_(a.in[I_A0][c0 + e] + la[e]); const float km = k[e] * (1.0f + (av - 1.0f) * a.in[I_KA][c0 + e]); bs += r[e] * km * a.in[I_RK][c0 + e]; }
        bs += __shfl_xor(bs, 1); bs += __shfl_xor(bs, 2);
        float o[16];
#pragma unroll
        for (int e = 0; e < 16; ++e) o[e] = ((y[e] - mean) * rstd * a.in[I_GNW][c0 + e] + a.in[I_GNB][c0 + e] + bs * v[e]) * gq[e];
        u32x4 w0, w1; w0.x = cvt_pk_bf16(o[0], o[1]); w0.y = cvt_pk_bf16(o[2], o[3]); w0.z = cvt_pk_bf16(o[4], o[5]); w0.w = cvt_pk_bf16(o[6], o[7]);
        w1.x = cvt_pk_bf16(o[8], o[9]); w1.y = cvt_pk_bf16(o[10], o[11]); w1.z = cvt_pk_bf16(o[12], o[13]); w1.w = cvt_pk_bf16(o[14], o[15]);
        *(u32x4*)(YG + off) = w0; *(u32x4*)(YG + off + 8) = w1;
    }
}
__device__ __forceinline__ void ph_conv(const Args& a, const Frame& F) {
    const bf16* XB = WSP(bf16, A_XB); bf16* XBC = WSP(bf16, A_XBC);
    const int gt = F.bid * NTHR + F.tid, NGT = F.G * NTHR;
    for (int it = gt; it < M * 128; it += NGT) {
        const int row = it >> 7, c0 = (it & 127) * 8, t = row & (T - 1);
        float acc[8];
#pragma unroll
        for (int e = 0; e < 8; ++e) acc[e] = a.in[I_CONVB][c0 + e];
#pragma unroll
        for (int j = 0; j < 4; ++j) { const int tt = t - 3 + j; if (tt >= 0) { float f[8]; unpack8(*(const u32x4*)(XB + (size_t)(row - 3 + j) * D + c0), f);
#pragma unroll
                for (int e = 0; e < 8; ++e) acc[e] += a.in[I_CONVW][j * D + c0 + e] * f[e]; } }
        u32x4 w; w.x = cvt_pk_bf16(acc[0], acc[1]); w.y = cvt_pk_bf16(acc[2], acc[3]); w.z = cvt_pk_bf16(acc[4], acc[5]); w.w = cvt_pk_bf16(acc[6], acc[7]);
        *(u32x4*)(XBC + (size_t)row * D + c0) = w;
    }
}
__global__ void __launch_bounds__(256) k_lru_naive(Args a) {
    const int id = blockIdx.x * 256 + threadIdx.x, b = id >> 10, c = id & 1023;
    const float* AT = WSP(float, A_AT); const float* BT = WSP(float, A_BT); const bf16* GATE = WSP(bf16, A_GATE); bf16* HG = WSP(bf16, A_HG);
    float h = 0.f;
    for (int t = 0; t < T; ++t) { const size_t off = (size_t)(b * T + t) * D + c; h = AT[off] * h + BT[off]; HG[off] = (bf16)(cvt_pk_bf16(h * bf2f(GATE[off]), 0.f) & 0xffffu); }
}
__device__ __forceinline__ void ph_route1(const Args& a, const Frame& F) {
    const xres_t* X = XRES(a); const float* mod = WSP(float, WS_MOD); bf16* H = WSP(bf16, A_H);
    LAS int* cnt = (LAS int*)F.lds;
    f32x4 wa[16], wb[16];
#pragma unroll
    for (int j = 0; j < 4; ++j)
#pragma unroll
        for (int i = 0; i < 4; ++i) { const int d = 4 * F.lane + 256 * j + i; wa[4 * j + i] = *(const f32x4*)(a.in[I_ROUTW] + d * 8); wb[4 * j + i] = *(const f32x4*)(a.in[I_ROUTW] + d * 8 + 4); }
    float rb[8];
#pragma unroll
    for (int e = 0; e < 8; ++e) rb[e] = a.in[I_ROUTB][e];
    for (int wg = F.bid; wg < M / 64; wg += F.G) {
        if (F.tid < 8) cnt[F.tid] = 0;
        __syncthreads();
        const int r0 = wg * 64 + F.wave * 8, b = r0 >> 12; const float* mb = mod + (size_t)(1 * 4 + b) * MODW + 3072;
        f32x4 gm[4], shv[4], h[4];
        load_gm_sh(a.in[I_NORMG] + (1 * 2 + 1) * D, mb + 0, mb + 1024, F.lane, gm, shv);
        for (int r = 0; r < 8; ++r) {
            const int row = r0 + r; mod_row(X + (size_t)row * D, gm, shv, F.lane, h);
#if MOE_FP8
            { unsigned char* h8 = (unsigned char*)H + (size_t)row * D;
#pragma unroll
              for (int j = 0; j < 4; ++j) *(unsigned*)(h8 + 4 * F.lane + 256 * j) = pk_fp8x4(h[j][0], h[j][1], h[j][2], h[j][3]); }
#else
            store_row_bf16(H + (size_t)row * D, h, F.lane);
#endif
            float lg[8];
#pragma unroll
            for (int e = 0; e < 8; ++e) lg[e] = 0.f;
#pragma unroll
            for (int j = 0; j < 4; ++j)
#pragma unroll
                for (int i = 0; i < 4; ++i) { const f32x4 w0 = wa[4 * j + i], w1 = wb[4 * j + i]; const float hv = h[j][i];
                    lg[0] += hv * w0[0]; lg[1] += hv * w0[1]; lg[2] += hv * w0[2]; lg[3] += hv * w0[3]; lg[4] += hv * w1[0]; lg[5] += hv * w1[1]; lg[6] += hv * w1[2]; lg[7] += hv * w1[3]; }
            { const bool up = (F.lane & 32) != 0; float t[4];
#pragma unroll
              for (int i = 0; i < 4; ++i) { const float keep = up ? lg[i + 4] : lg[i], send = up ? lg[i] : lg[i + 4]; t[i] = keep + __shfl_xor(send, 32); }
              const bool up2 = (F.lane & 16) != 0; float u2[2];
#pragma unroll
              for (int i = 0; i < 2; ++i) { const float keep = up2 ? t[i + 2] : t[i], send = up2 ? t[i] : t[i + 2]; u2[i] = keep + __shfl_xor(send, 16); }
              const bool up3 = (F.lane & 8) != 0; float v1 = (up3 ? u2[1] : u2[0]) + __shfl_xor(up3 ? u2[0] : u2[1], 8);
              v1 += __shfl_xor(v1, 4); v1 += __shfl_xor(v1, 2); v1 += __shfl_xor(v1, 1);
#pragma unroll
              for (int e = 0; e < 8; ++e) lg[e] = __builtin_bit_cast(float, __builtin_amdgcn_readlane(__builtin_bit_cast(int, v1), 8 * e)) + rb[e]; }
            int i0 = 0; float v0 = lg[0];
#pragma unroll
            for (int e = 1; e < 8; ++e) if (lg[e] > v0) { v0 = lg[e]; i0 = e; }
            int i1 = -1; float v1 = -3.0e38f;
#pragma unroll
            for (int e = 0; e < 8; ++e) if (e != i0 && lg[e] > v1) { v1 = lg[e]; i1 = e; }
            const float p0 = 1.0f / (1.0f + __expf(v1 - v0)), p1 = 1.0f - p0;
            if (F.lane == 0) { WSP(i32x2, WS_SEL)[row] = (i32x2){i0, i1}; WSP(f32x2, WS_PROB)[row] = (f32x2){p0, p1}; __hip_atomic_fetch_add(&cnt[i0], 1, __ATOMIC_RELAXED, __HIP_MEMORY_SCOPE_WORKGROUP); __hip_atomic_fetch_add(&cnt[i1], 1, __ATOMIC_RELAXED, __HIP_MEMORY_SCOPE_WORKGROUP); }
        }
        __syncthreads();
        if (F.tid < 8) WSP(int, WS_CNT)[wg * 8 + F.tid] = cnt[F.tid];
        __syncthreads();
    }
}
__device__ __forceinline__ void ph_route2(const Args& a, const Frame& F) {
    const bf16* H = WSP(bf16, A_H); bf16* HSb = WSP(bf16, A_HS); const int* CNT = WSP(int, WS_CNT);
    LAS int* lpos = (LAS int*)F.lds;
    LAS int* lps = lpos + 128;
    for (int wg = F.bid; wg < M / 64; wg += F.G) {
        if (F.wave == 0) {
            int below[8], tot[8];
#pragma unroll
            for (int e = 0; e < 8; ++e) { below[e] = 0; tot[e] = 0; }
#pragma unroll
            for (int q = 0; q < 4; ++q) { const int w = F.lane + 64 * q;
#pragma unroll
                for (int e = 0; e < 8; ++e) { const int cv = CNT[w * 8 + e]; tot[e] += cv; below[e] += (w < wg) ? cv : 0; } }
#pragma unroll
            for (int e = 0; e < 8; ++e)
#pragma unroll
                for (int o = 1; o < 64; o <<= 1) { tot[e] += __shfl_xor(tot[e], o); below[e] += __shfl_xor(below[e], o); }
            int ps[9]; ps[0] = 0;
#pragma unroll
            for (int e = 0; e < 8; ++e) ps[e + 1] = ps[e] + ((tot[e] + 255) & ~255);
            const int row = wg * 64 + F.lane; const i32x2 se = WSP(i32x2, WS_SEL)[row]; int p0 = 0, p1 = 0;
#pragma unroll
            for (int e = 0; e < 8; ++e) { const bool mine = (se.x == e) || (se.y == e); const unsigned long long mk = __ballot(mine); const int rank = __popcll(mk & ((1ull << F.lane) - 1ull));
                if (se.x == e) p0 = ps[e] + below[e] + rank; if (se.y == e) p1 = ps[e] + below[e] + rank; }
            WSP(i32x2, WS_POS)[row] = (i32x2){p0, p1}; lpos[2 * F.lane] = p0; lpos[2 * F.lane + 1] = p1;
            if (F.lane == 0) {
#pragma unroll
                for (int e = 0; e < 9; ++e) lps[e] = ps[e];
#pragma unroll
                for (int e = 0; e < 8; ++e) lps[16 + e] = tot[e];
                if (wg == 0) {
#pragma unroll
                    for (int e = 0; e < 9; ++e) WSP(int, WS_PST)[e] = ps[e]; }
            }
        }
        __syncthreads();
        for (int r = 0; r < 8; ++r) { const int tl = F.wave * 8 + r, row = wg * 64 + tl; const int p0 = lpos[2 * tl], p1 = lpos[2 * tl + 1];
#if MOE_FP8
            unsigned char* HS8 = (unsigned char*)HSb; const u32x4 v8 = *(const u32x4*)((const unsigned char*)H + (size_t)row * D + 16 * F.lane);
            *(u32x4*)(HS8 + (size_t)p0 * D + 16 * F.lane) = v8; *(u32x4*)(HS8 + (size_t)p1 * D + 16 * F.lane) = v8; }
        if (wg < 8) { const int e = wg, rs = lps[e] + lps[16 + e], re = lps[e + 1]; const u32x4 z = (u32x4){0u, 0u, 0u, 0u};
            for (int i = rs * 64 + F.tid; i < re * 64; i += NTHR) *(u32x4*)((unsigned char*)HSb + (size_t)i * 16) = z; }
#else
            const u32x4 v0 = *(const u32x4*)(H + (size_t)row * D + 8 * F.lane), v1 = *(const u32x4*)(H + (size_t)row * D + 512 + 8 * F.lane);
            *(u32x4*)(HSb + (size_t)p0 * D + 8 * F.lane) = v0; *(u32x4*)(HSb + (size_t)p0 * D + 512 + 8 * F.lane) = v1;
            *(u32x4*)(HSb + (size_t)p1 * D + 8 * F.lane) = v0; *(u32x4*)(HSb + (size_t)p1 * D + 512 + 8 * F.lane) = v1; }
        if (wg < 8) { const int e = wg, rs = lps[e] + lps[16 + e], re = lps[e + 1]; const u32x4 z = (u32x4){0u, 0u, 0u, 0u};
            for (int i = rs * 128 + F.tid; i < re * 128; i += NTHR) *(u32x4*)(HSb + (size_t)i * 8) = z; }
#endif
        __syncthreads();
    }
}
__device__ __forceinline__ void ph_final(const Args& a, const Frame& F, float* dst) {
    const xres_t* X = XRES(a); const float* mod = WSP(float, WS_MOD); const bf16* YD = WSP(bf16, A_YD);
    const int gw = F.bid * NWAVES + F.wave, NGW = F.G * NWAVES;
    f32x4 fg[4];
#pragma unroll
    for (int j = 0; j < 4; ++j) fg[j] = ((const f32x4*)a.in[I_FINALG])[F.lane + 64 * j];
    for (int rb = gw; rb < M / 8; rb += NGW) {
        const int r0 = rb * 8, b = r0 >> 12; const float* gt = mod + (size_t)(1 * 4 + b) * MODW + 5120;
        f32x4 g[4];
#pragma unroll
        for (int j = 0; j < 4; ++j) g[j] = ((const f32x4*)gt)[F.lane + 64 * j] + 1.0f;
#pragma unroll 2
        for (int r = 0; r < 8; ++r) { const int row = r0 + r;
            const i32x2 pos = WSP(i32x2, WS_POS)[row]; const f32x2 pr = WSP(f32x2, WS_PROB)[row];
            f32x4 v[4]; float ss = 0.f;
#pragma unroll
            for (int j = 0; j < 4; ++j) { const f32x4 xv = xload4(X + (size_t)row * D, F.lane + 64 * j), y0 = unpk4(((const u32x2*)(YD + (size_t)pos.x * D))[F.lane + 64 * j]), y1 = unpk4(((const u32x2*)(YD + (size_t)pos.y * D))[F.lane + 64 * j]);
                v[j] = xv + g[j] * (y0 * pr.x + y1 * pr.y); ss += (v[j][0] * v[j][0] + v[j][1] * v[j][1]) + (v[j][2] * v[j][2] + v[j][3] * v[j][3]); }
            ss = wave_sum(ss); const float rr = 1.0f / sqrtf(ss * (1.0f / D) + 1e-6f);
#pragma unroll
            for (int j = 0; j < 4; ++j) __builtin_nontemporal_store((v[j] * rr) * fg[j], (f32x4*)(dst + (size_t)row * D) + F.lane + 64 * j); }
    }
}
__device__ __forceinline__ void ph_final_plain(const Args& a, const Frame& F, const float* src) {
    float* X = a.out; const int gw = F.bid * NWAVES + F.wave, NGW = F.G * NWAVES;
    for (int row = gw; row < M; row += NGW) {
        f32x4 v[4]; float ss = 0.f;
#pragma unroll
        for (int j = 0; j < 4; ++j) { v[j] = ((const f32x4*)(src + (size_t)row * D))[F.lane + 64 * j]; ss += (v[j][0] * v[j][0] + v[j][1] * v[j][1]) + (v[j][2] * v[j][2] + v[j][3] * v[j][3]); }
        ss = wave_sum(ss); const float r = 1.0f / sqrtf(ss * (1.0f / D) + 1e-6f);
#pragma unroll
        for (int j = 0; j < 4; ++j) ((f32x4*)(X + (size_t)row * D))[F.lane + 64 * j] = (v[j] * r) * ((const f32x4*)a.in[I_FINALG])[F.lane + 64 * j];
    }
}
__device__ __forceinline__ void ph_dbgw(const Args& a, const Frame& F) {
    const int gt = F.bid * NTHR + F.tid, NGT = F.G * NTHR; const bf16* w1 = WSP(bf16, WS_WRKV); const bf16* w2 = WSP(bf16, WS_L1T); const bf16* w3 = WSP(bf16, WS_L2T);
    for (size_t i = gt; i < (size_t)M * D; i += NGT) { float v = a.in[I_X][i]; if (i < (size_t)3 * D * D) v += bf2f(w1[i]); if (i < (size_t)768 * D) v += bf2f(w2[i]); if (i < (size_t)3 * D * 256) v += bf2f(w3[i]); a.out[i] = v; }
}
__device__ __forceinline__ void ph_dbg(const Args& a, const Frame& F, const bf16* t1, const bf16* t2, const float* t3, size_t lim1 = (size_t)M * D) {
    const int gt = F.bid * NTHR + F.tid, NGT = F.G * NTHR;
    for (size_t i = gt; i < (size_t)M * D; i += NGT) { float v = a.in[I_X][i]; if (t1 && i < lim1) v += bf2f(t1[i]); if (t2) v += bf2f(t2[i]); if (t3) v += t3[i]; a.out[i] = v; }
}

struct OrderOwn { int pm, z; const char* A; const char* B;
    __device__ __forceinline__ bool next(int i, Unit& u) const { if (i >= 2) return false; u.pm = pm; u.pn = i; u.z = z; u.A = A; u.B = B + (size_t)i * 256 * 256 * 2; return true; } };
__device__ __forceinline__ void ph_cgl(const Args& a, const Frame& F) {
    const bf16* XB = WSP(bf16, A_XB); bf16* XBC = WSP(bf16, A_XBC); const bf16* AT = WSP(bf16, A_AT); const bf16* BT = WSP(bf16, A_BT); float* CAR = WSP(float, A_CAR);
    for (int task = F.bid; task < 256; task += F.G) {
        const int pm = task >> 2, z = task & 3;
        { const int cg = F.tid & 31, rbk = F.tid >> 5, c0 = z * 256 + cg * 8; float wt[4][8], bs[8];
#pragma unroll
          for (int e = 0; e < 8; ++e) bs[e] = a.in[I_CONVB][c0 + e];
#pragma unroll
          for (int j = 0; j < 4; ++j)
#pragma unroll
              for (int e = 0; e < 8; ++e) wt[j][e] = a.in[I_CONVW][j * D + c0 + e];
#pragma unroll 1
          for (int hf = 0; hf < 2; ++hf) { const int R0 = pm * 256 + rbk * 16 + hf * 8, t0 = R0 & (T - 1); u32x4 in[11];
#pragma unroll
              for (int i = 0; i < 11; ++i) { const int rr_ = (t0 - 3 + i >= 0) ? R0 - 3 + i : R0; in[i] = *(const u32x4*)(XB + (size_t)rr_ * D + c0); if (t0 - 3 + i < 0) in[i] = (u32x4){0u, 0u, 0u, 0u}; }
#pragma unroll
              for (int r = 0; r < 8; ++r) { float acc[8];
#pragma unroll
                  for (int e = 0; e < 8; ++e) acc[e] = bs[e];
#pragma unroll
                  for (int j = 0; j < 4; ++j) { float f[8]; unpack8(in[r + j], f);
#pragma unroll
                      for (int e = 0; e < 8; ++e) acc[e] += wt[j][e] * f[e]; }
                  u32x4 w; w.x = cvt_pk_bf16(acc[0], acc[1]); w.y = cvt_pk_bf16(acc[2], acc[3]); w.z = cvt_pk_bf16(acc[4], acc[5]); w.w = cvt_pk_bf16(acc[6], acc[7]);
                  *(u32x4*)(XBC + (size_t)(R0 + r) * D + c0) = w; } } }
        asm volatile("s_waitcnt vmcnt(0)" ::: "memory"); __syncthreads();
        { OrderOwn S{pm, z, (const char*)(XBC + (size_t)pm * 256 * D + z * 256), (const char*)(WSP(bf16, WS_WG) + (size_t)z * 512 * 256)};
          EpiGates E{a.in[I_BGATES], a.in[I_LAM], XBC, WSP(bf16, A_AT), WSP(bf16, A_BT)}; gemm_run(F.lds, GemmDims{256, D, 256}, S, E); }
        asm volatile("s_waitcnt vmcnt(0)" ::: "memory"); __syncthreads();
        { const int chl = F.tid >> 7, c = z * 256 + 2 * (F.tid & 127), row0 = pm * 256 + chl * 64, b = row0 >> 12, ch = (row0 & (T - 1)) >> 6; const size_t off = (size_t)row0 * D + c;
          float P0 = 1.f, P1 = 1.f, h0 = 0.f, h1 = 0.f;
#pragma unroll 1
          for (int tb = 0; tb < 64; tb += 16) { unsigned aw[16], bw[16];
#pragma unroll
              for (int t = 0; t < 16; ++t) { aw[t] = *(const unsigned*)(AT + off + (size_t)(tb + t) * D); bw[t] = *(const unsigned*)(BT + off + (size_t)(tb + t) * D); }
#pragma unroll
              for (int t = 0; t < 16; ++t) { const float a0 = __expf(bf2f(aw[t] & 0xffffu)), a1 = __expf(__uint_as_float(aw[t] & 0xffff0000u)); h0 = a0 * h0 + bf2f(bw[t] & 0xffffu); h1 = a1 * h1 + __uint_as_float(bw[t] & 0xffff0000u); P0 *= a0; P1 *= a1; } }
          *(f32x2*)(CAR + ((size_t)(b * 64 + ch) * 2 + 0) * D + c) = (f32x2){P0, P1}; *(f32x2*)(CAR + ((size_t)(b * 64 + ch) * 2 + 1) * D + c) = (f32x2){h0, h1}; }
        __syncthreads();
    }
}
#if WKV_MODE == 0
#define WKV_PHASES PH_WKV, PH_POST,
#elif WKV_MODE == 1
#define WKV_PHASES PH_WKV, PH_WKV_A, PH_WKV_C,
#else
#define WKV_PHASES PH_WKV_A, PH_WKV_B, PH_WKV_C,
#endif
#if FUSE_MOD
#define MOD1_PHASE
#define MOD2_PHASE
#else
#define MOD1_PHASE PH_MOD1,
#define MOD2_PHASE PH_MOD2,
#endif
enum { PH_PROLOGUE = 0, PH_SHIFT, PH_G_RKV, PH_G_L2, WKV_PHASES PH_G_WO, MOD1_PHASE PH_G_GU, PH_G_DOWN, MOD2_PHASE PH_G_WIN, PH_CGL, PH_LRU2, PH_G_WOUT, PH_R1, PH_R2, PH_G_MGU, PH_G_MD, PH_FINAL, PH_NMAIN, PH_PLAIN_X, PH_PLAIN_OUT, PH_DBG1, PH_DBG2, PH_DBG3, PH_DBG0, PH_DBGW, PH_CONV, PH_G_GATES, PH_LRU1,
#if WKV_MODE == 0
       PH_WKV_A, PH_WKV_B, PH_WKV_C,
#elif WKV_MODE == 1
       PH_WKV_B, PH_POST,
#else
       PH_WKV, PH_POST,
#endif
#if FUSE_MOD
       PH_MOD1, PH_MOD2,
#endif
       PH_COUNT };

template <int PH, bool PROBE_SCRATCH = false>
__device__ __forceinline__ void run_phase(const Args& a, const Frame& F) {
    const float* mod = WSP(float, WS_MOD);
    if constexpr (PH == PH_PROLOGUE) ph_prologue(a, F);
    if constexpr (PH == PH_SHIFT) ph_shift(a, F);
    if constexpr (PH == PH_G_RKV) { OrderRKV S{F.G, F.bid, (const char*)WSP(bf16, A_XM), (const char*)WSP(bf16, WS_WRKV), (const char*)WSP(bf16, WS_L1T)}; EpiRKV E{WSP(bf16, A_RKV), WSP(bf16, A_L1O)};
        gemm_run(F.lds, GemmDims{D, D, D}, S, E); }
    if constexpr (PH == PH_G_L2) { BatchOrder S{64, 4, 3, F.G, F.bid, (const char*)WSP(bf16, A_L1O), (size_t)M * 256 * 2, (size_t)256 * 256 * 2, (const char*)WSP(bf16, WS_L2T), (size_t)D * 256 * 2, (size_t)256 * 256 * 2};
        EpiBf16 E{WSP(bf16, A_L2O), (size_t)M * D, D}; gemm_run(F.lds, GemmDims{256, 256, 256}, S, E); }
    if constexpr (PH == PH_WKV) ph_wkv(a, F);
    if constexpr (PH == PH_WKV_A) ph_wkv_a(a, F);
    if constexpr (PH == PH_WKV_B) ph_wkv_b(a, F);
    if constexpr (PH == PH_WKV_C) ph_wkv_c(a, F);
    if constexpr (PH == PH_LRU1) ph_lru1(a, F);
    if constexpr (PH == PH_LRU2) ph_lru2(a, F);
    if constexpr (PH == PH_POST) ph_post(a, F);
    if constexpr (PH == PH_G_WO) { BatchOrder S{64, 4, 1, F.G, F.bid, (const char*)WSP(bf16, A_YG), 0, (size_t)256 * D * 2, (const char*)WSP(bf16, WS_WO), 0, (size_t)256 * D * 2};
        { EpiResT<float, xres_t> E{a.in[I_X], XRES(a), mod + 0 * 4 * MODW + 2048}; gemm_run(F.lds, GemmDims{D, D, D}, S, E); } }
    if constexpr (PH == PH_MOD1) ph_modulate(a, F, 0, 1, FFN_I8 ? 2 : (FFN_FP8 ? 1 : 0));
#if FFN_I8
    if constexpr (PH == PH_G_GU) { BatchOrder S{64, 28, 1, F.G, F.bid, (const char*)(a.ws + A_H), 0, (size_t)256 * D, (const char*)(a.ws + WS_WGU), 0, (size_t)256 * D};
        EpiGUi8 E{WSP(bf16, A_ACT), WSP(float, WS_SA), (const unsigned*)(CTLP + 32)}; gemm_run<EpiGUi8, BatchOrder, 2>(F.lds, GemmDims{D / 2, D / 2, D / 2}, S, E); }
#elif FFN_FP8
    if constexpr (PH == PH_G_GU) { BatchOrder S{64, 28, 1, F.G, F.bid, (const char*)(a.ws + A_H), 0, (size_t)256 * D, (const char*)(a.ws + WS_WGU), 0, (size_t)256 * D};
        EpiGU8 E{a.ws + A_ACT}; gemm_run<EpiGU8, BatchOrder, 1>(F.lds, GemmDims{D / 2, D / 2, D / 2}, S, E); }
#else
    if constexpr (PH == PH_G_GU) { BatchOrder S{64, 28, 1, F.G, F.bid, (const char*)WSP(bf16, A_H), 0, (size_t)256 * D * 2, (const char*)WSP(bf16, WS_WGU), 0, (size_t)256 * D * 2};
        EpiGU E{WSP(bf16, A_ACT)}; gemm_run(F.lds, GemmDims{D, D, D}, S, E); }
#endif
    if constexpr (PH == PH_G_DOWN) { BatchOrder S{64, 4, 1, F.G, F.bid, (const char*)WSP(bf16, A_ACT), 0, (size_t)256 * FF * (FFN_FP8 ? 1 : 2), (const char*)WSP(bf16, WS_WD), 0, (size_t)256 * FF * (FFN_FP8 ? 1 : 2)};
        { EpiResT<xres_t, xres_t> E{XRES(a), PROBE_SCRATCH ? (xres_t*)(a.ws + WS_END) : XRES(a), mod + 0 * 4 * MODW + 5120}; gemm_run<decltype(E), BatchOrder, (FFN_FP8 != 0) ? 1 : 0>(F.lds, FFN_FP8 ? GemmDims{FF / 2, FF / 2, FF / 2} : GemmDims{FF, FF, FF}, S, E); } }
    if constexpr (PH == PH_MOD2) ph_modulate(a, F, 1, 0);
    if constexpr (PH == PH_G_WIN) { BatchOrder S{64, 8, 1, F.G, F.bid, (const char*)WSP(bf16, A_H), 0, (size_t)256 * D * 2, (const char*)WSP(bf16, WS_WIN), 0, (size_t)256 * D * 2};
        EpiWin E{WSP(bf16, A_XB), WSP(bf16, A_GATE)}; gemm_run(F.lds, GemmDims{D, D, D}, S, E); }
    if constexpr (PH == PH_CGL) ph_cgl(a, F);
    if constexpr (PH == PH_CONV) ph_conv(a, F);
    if constexpr (PH == PH_G_GATES) { BatchOrder S{64, 2, 4, F.G, F.bid, (const char*)WSP(bf16, A_XBC), (size_t)256 * 2, (size_t)256 * D * 2, (const char*)WSP(bf16, WS_WG), (size_t)512 * 256 * 2, (size_t)256 * 256 * 2};
        EpiGates E{a.in[I_BGATES], a.in[I_LAM], WSP(bf16, A_XBC), WSP(bf16, A_AT), WSP(bf16, A_BT)}; gemm_run(F.lds, GemmDims{256, D, 256}, S, E); }
    if constexpr (PH == PH_G_WOUT) { BatchOrder S{64, 4, 1, F.G, F.bid, (const char*)WSP(bf16, A_HG), 0, (size_t)256 * D * 2, (const char*)WSP(bf16, WS_WOUT), 0, (size_t)256 * D * 2};
        EpiResT<xres_t, xres_t> E{XRES(a), PROBE_SCRATCH ? (xres_t*)(a.ws + WS_END) : XRES(a), mod + 1 * 4 * MODW + 2048}; gemm_run(F.lds, GemmDims{D, D, D}, S, E); }
    if constexpr (PH == PH_R1) ph_route1(a, F);
    if constexpr (PH == PH_R2) ph_route2(a, F);
#if MOE_FP8
    if constexpr (PH == PH_G_MGU) { MoeOrder S; S.G = F.G; S.c = F.bid; S.nN = 28; S.load(WSP(int, WS_PST), F.lds); S.A = (const char*)(a.ws + A_HS); S.am = (size_t)256 * D; S.B = (const char*)(a.ws + WS_MGU); S.be = (size_t)2 * FF * D; S.bn = (size_t)256 * D;
        EpiGU8 E{a.ws + A_MACT}; gemm_run<EpiGU8, MoeOrder, 1>(F.lds, GemmDims{D / 2, D / 2, D / 2}, S, E); }
    if constexpr (PH == PH_G_MD) { MoeOrder S; S.G = F.G; S.c = F.bid; S.nN = 4; S.load(WSP(int, WS_PST), F.lds); S.A = (const char*)(a.ws + A_MACT); S.am = (size_t)256 * FF; S.B = (const char*)(a.ws + WS_MD); S.be = (size_t)D * FF; S.bn = (size_t)256 * FF;
#if MD_TAIL
        const int units = S.p[8] * 4, L0 = (units / F.G) * F.G, R = units - L0, SP = (R == 0) ? 1 : ((R * 7 <= F.G) ? 7 : ((R * 2 <= F.G) ? 2 : 1)); S.lim = L0;
#endif
        EpiBf16 E{WSP(bf16, A_YD), 0, D}; gemm_run<EpiBf16, MoeOrder, 1>(F.lds, GemmDims{FF / 2, FF / 2, FF / 2}, S, E);
#if MD_TAIL
        if (R > 0) { MoeTail S2{F.bid, 4, S.p, S.A, S.am, S.B, S.be, S.bn, L0, R, SP, (size_t)(FF / SP)}; EpiPart E2{WSP(bf16, A_YDP)};
            gemm_run<EpiPart, MoeTail, 1>(F.lds, GemmDims{FF / 2 / SP, FF / 2, FF / 2}, S2, E2);
            if (F.bid < R * SP) {
                const int s = F.bid / R, j = F.bid - s * R; unsigned* ctl = (unsigned*)(CTLP);
                if (F.tid == 0) { __builtin_amdgcn_fence(__ATOMIC_RELEASE, "agent"); (void)xb_add(&ctl[CW_TAIL + j], 1u); XB_SPIN(xb_ld(&ctl[CW_TAIL + j]) < (unsigned)SP, ctl + CW_BAR); __builtin_amdgcn_fence(__ATOMIC_ACQUIRE, "agent"); }
                __syncthreads();
                int pm, pn; map_unit(L0 + j, S.p[8], 4, pm, pn);
                const int r0 = s * 256 / SP, r1 = (s + 1) * 256 / SP; const bf16* P = WSP(bf16, A_YDP); bf16* YD = WSP(bf16, A_YD) + (size_t)pm * 256 * D + pn * 256;
                for (int idx = F.tid; idx < (r1 - r0) * 32; idx += NTHR) { const int r = r0 + (idx >> 5), c8 = (idx & 31) * 8; float sum[8] = {0.f, 0.f, 0.f, 0.f, 0.f, 0.f, 0.f, 0.f};
#pragma unroll 1
                    for (int s2 = 0; s2 < SP; ++s2) { float v[8]; unpack8(*(const u32x4*)(P + (size_t)(s2 * R + j) * 65536 + r * 256 + c8), v);
#pragma unroll
                        for (int e = 0; e < 8; ++e) sum[e] += v[e]; }
                    st_bf16x8(YD + (size_t)r * D + c8, (f32x4){sum[0], sum[1], sum[2], sum[3]}, (f32x4){sum[4], sum[5], sum[6], sum[7]}); } } }
#endif
    }
#else
    if constexpr (PH == PH_G_MGU) { MoeOrder S; S.G = F.G; S.c = F.bid; S.nN = 28; S.load(WSP(int, WS_PST), F.lds); S.A = (const char*)WSP(bf16, A_HS); S.am = (size_t)256 * D * 2; S.B = (const char*)WSP(bf16, WS_MGU); S.be = (size_t)2 * FF * D * 2; S.bn = (size_t)256 * D * 2;
        EpiGU E{WSP(bf16, A_MACT)}; gemm_run(F.lds, GemmDims{D, D, D}, S, E); }
    if constexpr (PH == PH_G_MD) { MoeOrder S; S.G = F.G; S.c = F.bid; S.nN = 4; S.load(WSP(int, WS_PST), F.lds); S.A = (const char*)WSP(bf16, A_MACT); S.am = (size_t)256 * FF * 2; S.B = (const char*)WSP(bf16, WS_MD); S.be = (size_t)D * FF * 2; S.bn = (size_t)256 * FF * 2;
        EpiBf16 E{WSP(bf16, A_YD), 0, D}; gemm_run(F.lds, GemmDims{FF, FF, FF}, S, E); }
#endif
    if constexpr (PH == PH_FINAL) ph_final(a, F, PROBE_SCRATCH ? WSP(float, WS_END) : a.out);
    if constexpr (PH == PH_DBG0) ph_dbg(a, F, WSP(bf16, A_XM) + (size_t)5 * M * D, WSP(bf16, A_XM), nullptr);
    if constexpr (PH == PH_DBGW) ph_dbgw(a, F);
    if constexpr (PH == PH_DBG1) ph_dbg(a, F, WSP(bf16, A_L2O), WSP(bf16, A_L2O) + (size_t)M * D, nullptr);
    if constexpr (PH == PH_DBG2) ph_dbg(a, F, nullptr, nullptr, WSP(float, A_Y));
    if constexpr (PH == PH_DBG3) ph_dbg(a, F, WSP(bf16, A_YG), nullptr, nullptr);
    if constexpr (PH == PH_PLAIN_X) ph_final_plain(a, F, a.in[I_X]);
    if constexpr (PH == PH_PLAIN_OUT) ph_final_plain(a, F, a.out);
}

template <int PH>
__global__ void __launch_bounds__(NTHR, 2) k_ph(Args a) {
    __shared__ __attribute__((aligned(16))) unsigned char lds[LDS_BYTES];
    Frame F; F.lds = (LAS unsigned char*)lds; F.tid = threadIdx.x; F.lane = F.tid & 63; F.wave = __builtin_amdgcn_readfirstlane(F.tid >> 6); F.G = gridDim.x; F.bid = blockIdx.x;
    run_phase<PH>(a, F);
}
__device__ __forceinline__ Frame make_frame(LAS unsigned char* lds) {
    int t = threadIdx.x; asm volatile("" : "+v"(t));
    Frame F; F.lds = lds; F.tid = t; F.lane = t & 63; F.wave = __builtin_amdgcn_readfirstlane(t >> 6); F.G = gridDim.x; F.bid = blockIdx.x; return F;
}
template <int PH>
__device__ __forceinline__ void run_all(const Args& a, LAS unsigned char* lds, const XcdBarrier& bar) {
    if constexpr (PH < PH_NMAIN) {
#if defined(PROBE_MASK)
        if constexpr (((PROBE_MASK) >> PH) & 1) {
#pragma unroll 1
            for (int r_ = 0; r_ < PROBE_REP; ++r_) { const Frame Fp = make_frame(lds); run_phase<PH, true>(a, Fp); xcd_barrier(bar); } }
#endif
        { const Frame F = make_frame(lds); run_phase<PH>(a, F); }
        if constexpr (PH + 1 < PH_NMAIN) { xcd_barrier(bar);
#if defined(PROBE_BAR)
            xcd_barrier(bar);
#endif
        }
        run_all<PH + 1>(a, lds, bar); }
}
__global__ void __launch_bounds__(NTHR, 2) k_mega(Args a) {
    __shared__ __attribute__((aligned(16))) unsigned char lds[LDS_BYTES];
    Frame F; F.lds = (LAS unsigned char*)lds; F.tid = threadIdx.x; F.lane = F.tid & 63; F.wave = __builtin_amdgcn_readfirstlane(F.tid >> 6); F.G = gridDim.x; F.bid = blockIdx.x;
    volatile LAS unsigned* misc = (volatile LAS unsigned*)(F.lds + MISC_OFF);
    if (F.tid < 16) misc[F.tid] = 0u;
    __syncthreads();
    const XcdBarrier bar = xcd_barrier_post((unsigned*)(CTLP) + CW_BAR, misc + 8);
    run_all<0>(a, F.lds, bar);
    __syncthreads();
    if (F.tid == 0) { const unsigned old = xb_add(&g_ctl[16], 1u); misc[0] = (old == (unsigned)F.G - 1u) ? 1u : 0u; }
    __syncthreads();
    if (misc[0]) { for (int i = F.tid; i < (int)(CTL_ZERO_BYTES / 4); i += NTHR) g_ctl[i] = 0u; }
}
template <int PH>
static void launch_all(const Args& a, hipStream_t stream) {
    if constexpr (PH < PH_NMAIN) { hipLaunchKernelGGL(k_ph<PH>, dim3(256), dim3(NTHR), 0, stream, a); launch_all<PH + 1>(a, stream); }
}
#ifndef MEGA
#define MEGA 1
#endif
extern "C" void kernel_launch(void* const* d_in, const int* in_sizes, int n_in, void* d_out, int out_size, void* d_ws, size_t ws_size, hipStream_t stream) {
    if (n_in != 35 || out_size != M * D || ws_size < WS_END) { fprintf(stderr, "kernel_launch: unexpected shapes (n_in %d, out %d, ws %zu, need %zu)\n", n_in, out_size, ws_size, (size_t)WS_END); return; }
    Args a{};
    for (int i = 0; i < 35; ++i) a.in[i] = (const float*)d_in[i];
    a.out = (float*)d_out; a.ws = (unsigned char*)d_ws;
#if MEGA
    hipLaunchKernelGGL(k_mega, dim3(256), dim3(NTHR), 0, stream, a);
#else
    launch_all<0>(a, stream);
#endif
}
```
